# Optimizing an MI355X kernel written in HIP

```python
import jax, jax.numpy as jnp
from jax import lax
import numpy as np

D_MODEL = 1024
BATCH = 4
SEQ = 8192
DEPTH = 1

MIX_WIDTH = D_MODEL
RET_HEADS = 4
RET_DK = MIX_WIDTH // 2 // RET_HEADS
RET_DV = MIX_WIDTH // 2 // RET_HEADS
RET_CHUNK = 128
ATT_HEADS = 4
ATT_DH = MIX_WIDTH // 2 // ATT_HEADS
DILATED_CONFIGS = ((128, 1), (512, 4), (2048, 16))
ATT_BLOCK = 128
ROPE_THETA = 10000.0
N_EXPERTS = 32
TOP_K = 4
D_EXPERT = D_MODEL
SWIGLU_LIMIT = 7.0
SWIGLU_ALPHA = 1.702
MOE_BLOCK = 128
NORM_EPS = 1e-5
IN_SIZES = (RET_HEADS * RET_DK, RET_HEADS * RET_DK, RET_HEADS * RET_DV, RET_HEADS * RET_DV,
            ATT_HEADS * ATT_DH, ATT_HEADS * ATT_DH, ATT_HEADS * ATT_DH)
D_IN = sum(IN_SIZES)
D_CAT = RET_HEADS * RET_DV + ATT_HEADS * ATT_DH

kernel_name = "hybrid_retention_dilated_moe_block"


def rms_norm(x, g):
    xf = x.astype(jnp.float32)
    y = xf * lax.rsqrt(jnp.mean(xf * xf, axis=-1, keepdims=True) + NORM_EPS)
    return (y * g.astype(jnp.float32)).astype(x.dtype)


def rotary(t, pos):
    dh = t.shape[-1]
    inv = ROPE_THETA ** (-jnp.arange(0, dh, 2, dtype=jnp.float32) / dh)
    ang = pos[:, None] * inv[None, :]
    cos = jnp.cos(ang)[None, :, None, :].astype(t.dtype)
    sin = jnp.sin(ang)[None, :, None, :].astype(t.dtype)
    t1, t2 = t[..., : dh // 2], t[..., dh // 2:]
    return jnp.concatenate([t1 * cos - t2 * sin, t1 * sin + t2 * cos], axis=-1)


def retention_chunkwise(q, k, v):
    B, S, H, Dk = q.shape
    Dv = v.shape[-1]
    C = RET_CHUNK
    N = S // C
    log_g = jnp.log1p(-(2.0 ** (-5.0 - jnp.arange(H, dtype=jnp.float32))))
    idx = jnp.arange(C, dtype=jnp.float32)
    diff = idx[:, None] - idx[None, :]
    intra_decay = jnp.where(diff[None] >= 0, jnp.exp(jnp.maximum(diff, 0.0)[None] * log_g[:, None, None]), 0.0)
    zeta = jnp.exp((C - 1 - idx)[None, :] * log_g[:, None])
    xi = jnp.exp((idx + 1)[None, :] * log_g[:, None])
    chunk_decay = jnp.exp(C * log_g)
    dt = q.dtype
    qc = q.reshape(B, N, C, H, Dk)
    kc = k.reshape(B, N, C, H, Dk)
    vc = v.reshape(B, N, C, H, Dv)
    s = jnp.einsum('bnihd,bnjhd->bnhij', qc, kc) * intra_decay.astype(dt)[None, None]
    intra = jnp.einsum('bnhij,bnjhe->bnihe', s, vc)
    kv = jnp.einsum('bnjhd,bnjhe,hj->nbhde', kc, vc, zeta.astype(dt))
    dec = chunk_decay.astype(dt)[None, :, None, None]

    def step(state, kv_n):
        return state * dec + kv_n, state

    _, state_prev = lax.scan(step, jnp.zeros((B, H, Dk, Dv), dt), kv)
    cross = jnp.einsum('bnihd,nbhde,hi->bnihe', qc, state_prev, xi.astype(dt))
    return (intra + cross).reshape(B, S, H, Dv)


def head_group_norm(o):
    of = o.astype(jnp.float32)
    mu = jnp.mean(of, axis=-1, keepdims=True)
    var = jnp.mean(jnp.square(of - mu), axis=-1, keepdims=True)
    return ((of - mu) * lax.rsqrt(var + NORM_EPS)).astype(o.dtype)


def dilated_branch(q, k, v, window, dilation):
    B, S, H, Dh = q.shape
    n_back = window // dilation
    L = S // dilation
    nb = -(-L // ATT_BLOCK)
    Lp = nb * ATT_BLOCK

    def to_sub(t):
        t = t.reshape(B, L, dilation, H, Dh).transpose(0, 2, 3, 1, 4)
        t = jnp.pad(t, ((0, 0), (0, 0), (0, 0), (0, Lp - L), (0, 0)))
        return t.reshape(B, dilation, H, nb, ATT_BLOCK, Dh)

    qs, ks, vs = to_sub(q), to_sub(k), to_sub(v)

    def with_prev(t):
        prev = jnp.concatenate([jnp.zeros_like(t[:, :, :, :1]), t[:, :, :, :-1]], axis=3)
        return jnp.concatenate([prev, t], axis=4)

    kk, vv = with_prev(ks), with_prev(vs)
    s = jnp.einsum('brhnqc,brhnkc->brhnqk', qs, kk).astype(jnp.float32)
    qi = jnp.arange(ATT_BLOCK)[:, None]
    kj = jnp.arange(2 * ATT_BLOCK)[None, :]
    dist = qi + ATT_BLOCK - kj
    band = (dist >= 0) & (dist <= n_back)
    blk = jnp.arange(nb)[:, None, None]
    valid = band[None] & ((kj[None] >= ATT_BLOCK) | (blk > 0))
    s = jnp.where(valid, s, -jnp.inf)
    m = jnp.max(s, axis=-1, keepdims=True)
    p = jnp.exp(s - m)
    den = jnp.sum(p, axis=-1, keepdims=True)
    o = jnp.einsum('brhnqk,brhnkc->brhnqc', p.astype(v.dtype), vv) / den.astype(v.dtype)
    lse = (m + jnp.log(den))[..., 0]
    o = o.reshape(B, dilation, H, Lp, Dh)[:, :, :, :L].transpose(0, 3, 1, 2, 4).reshape(B, S, H, Dh)
    lse = lse.reshape(B, dilation, H, Lp)[:, :, :, :L].transpose(0, 3, 1, 2).reshape(B, S, H)
    return o, lse


def dilated_mixture(q, k, v):
    outs, lses = [], []
    for window, dilation in DILATED_CONFIGS:
        o, lse = dilated_branch(q, k, v, window, dilation)
        outs.append(o)
        lses.append(lse)
    w = jax.nn.softmax(jnp.stack(lses, axis=0), axis=0)
    o = jnp.stack(outs, axis=0)
    return jnp.sum(w.astype(q.dtype)[..., None] * o, axis=0)


def hybrid_mixer(h, w_in, w_out, pos):
    B, S, _ = h.shape
    proj = h @ w_in
    offsets = list(np.cumsum(IN_SIZES)[:-1])
    rq, rk, rv, rg, aq, ak, av = jnp.split(proj, offsets, axis=-1)
    rq = rotary(rq.reshape(B, S, RET_HEADS, RET_DK), pos)
    rk = rotary(rk.reshape(B, S, RET_HEADS, RET_DK), pos) * (RET_DK ** -0.5)
    rv = rv.reshape(B, S, RET_HEADS, RET_DV)
    ret = head_group_norm(retention_chunkwise(rq, rk, rv)).reshape(B, S, RET_HEADS * RET_DV)
    ret = jax.nn.silu(rg) * ret
    aq = rotary(aq.reshape(B, S, ATT_HEADS, ATT_DH), pos) * (ATT_DH ** -0.5)
    ak = rotary(ak.reshape(B, S, ATT_HEADS, ATT_DH), pos)
    av = av.reshape(B, S, ATT_HEADS, ATT_DH)
    att = dilated_mixture(aq, ak, av).reshape(B, S, ATT_HEADS * ATT_DH)
    return jnp.concatenate([ret, att], axis=-1) @ w_out


def clamped_swiglu_expert(xb, w_gu, b_gu, w_dn, b_dn):
    gu = xb @ w_gu + b_gu
    x_glu, x_lin = gu[..., :D_EXPERT], gu[..., D_EXPERT:]
    x_glu = jnp.minimum(x_glu, SWIGLU_LIMIT)
    x_lin = jnp.clip(x_lin, -SWIGLU_LIMIT, SWIGLU_LIMIT)
    act = x_glu * jax.nn.sigmoid(SWIGLU_ALPHA * x_glu) * (x_lin + 1.0)
    return act @ w_dn + b_dn


def moe_ffn(h, w_router, b_router, w_gate_up, b_gate_up, w_down, b_down):
    B, S, D = h.shape
    T = B * S
    ht = h.reshape(T, D)
    logits = (ht @ w_router + b_router).astype(jnp.float32)
    top_val, top_idx = lax.top_k(logits, TOP_K)
    gates = jax.nn.softmax(top_val, axis=-1).astype(h.dtype)
    A = T * TOP_K
    e_flat = top_idx.reshape(A).astype(jnp.int32)
    g_flat = gates.reshape(A)
    tok_flat = jnp.arange(A, dtype=jnp.int32) // TOP_K
    order = jnp.argsort(e_flat, stable=True)
    e_sorted = e_flat[order]
    counts = jnp.bincount(e_flat, length=N_EXPERTS)
    padded = (counts + MOE_BLOCK - 1) // MOE_BLOCK * MOE_BLOCK
    start = jnp.cumsum(counts) - counts
    pend = jnp.cumsum(padded)
    pstart = pend - padded
    dest = pstart[e_sorted] + (jnp.arange(A, dtype=jnp.int32) - start[e_sorted])
    P = A + N_EXPERTS * MOE_BLOCK
    n_blk = P // MOE_BLOCK
    rows_tok = jnp.zeros((P,), jnp.int32).at[dest].set(tok_flat[order])
    rows_gate = jnp.zeros((P,), h.dtype).at[dest].set(g_flat[order])
    blk_expert = jnp.minimum(
        jnp.searchsorted(pend, jnp.arange(n_blk, dtype=jnp.int32) * MOE_BLOCK, side='right'),
        N_EXPERTS - 1).astype(jnp.int32)
    xb = ht[rows_tok].reshape(n_blk, MOE_BLOCK, D)

    def run_block(args):
        xblk, e = args
        return clamped_swiglu_expert(xblk, w_gate_up[e], b_gate_up[e], w_down[e], b_down[e])

    yb = lax.map(run_block, (xb, blk_expert)).reshape(P, D)
    y = jnp.zeros((T, D), h.dtype).at[rows_tok].add(yb * rows_gate[:, None])
    return y.reshape(B, S, D)


def setup_inputs(seed: int = 0) -> dict:
    key = jax.random.key(seed)
    ks = jax.random.split(key, 12)
    f32 = jnp.float32
    nrm = lambda k, shape, scale: jax.random.normal(k, shape, f32) * scale
    return {
        "x": nrm(ks[0], (BATCH, SEQ, D_MODEL), 1.0),
        "norm_mix_g": 1.0 + nrm(ks[1], (DEPTH, D_MODEL), 0.02),
        "w_in": nrm(ks[2], (DEPTH, D_MODEL, D_IN), D_MODEL ** -0.5),
        "w_out": nrm(ks[3], (DEPTH, D_CAT, D_MODEL), D_CAT ** -0.5),
        "norm_ffn_g": 1.0 + nrm(ks[4], (DEPTH, D_MODEL), 0.02),
        "w_router": nrm(ks[5], (DEPTH, D_MODEL, N_EXPERTS), D_MODEL ** -0.5),
        "b_router": nrm(ks[6], (DEPTH, N_EXPERTS), 0.01),
        "w_gate_up": nrm(ks[7], (DEPTH, N_EXPERTS, D_MODEL, 2 * D_EXPERT), D_MODEL ** -0.5),
        "b_gate_up": nrm(ks[8], (DEPTH, N_EXPERTS, 2 * D_EXPERT), 0.01),
        "w_down": nrm(ks[9], (DEPTH, N_EXPERTS, D_EXPERT, D_MODEL), D_EXPERT ** -0.5),
        "b_down": nrm(ks[10], (DEPTH, N_EXPERTS, D_MODEL), 0.01),
        "norm_final_g": 1.0 + nrm(ks[11], (D_MODEL,), 0.02),
    }


def reference(x, norm_mix_g, w_in, w_out, norm_ffn_g, w_router, b_router,
              w_gate_up, b_gate_up, w_down, b_down, norm_final_g):
    S = x.shape[1]
    pos = jnp.arange(S, dtype=jnp.float32)
    for l in range(DEPTH):
        x = x + hybrid_mixer(rms_norm(x, norm_mix_g[l]), w_in[l], w_out[l], pos)
        x = x + moe_ffn(rms_norm(x, norm_ffn_g[l]), w_router[l], b_router[l],
                        w_gate_up[l], b_gate_up[l], w_down[l], b_down[l])
    return rms_norm(x, norm_final_g)
```

```cpp
#include <hip/hip_runtime.h>
#include <cstdio>
#include <cstdint>

#ifndef MK_N_LAUNCHES
#define MK_N_LAUNCHES 1
#endif

#ifndef REP_NOEPI
#define REP_NOEPI 0
#endif
#ifndef REP_PH
#define REP_PH (-1)
#endif

#define LAS __attribute__((address_space(3)))
#define GAS __attribute__((address_space(1)))
typedef unsigned short bf16_t;
typedef short bf16x8 __attribute__((ext_vector_type(8)));
typedef short s16x4 __attribute__((ext_vector_type(4)));
typedef float f32x4 __attribute__((ext_vector_type(4)));
typedef float f32x2 __attribute__((ext_vector_type(2)));
typedef unsigned u32x4 __attribute__((ext_vector_type(4)));
typedef unsigned u32x2 __attribute__((ext_vector_type(2)));
typedef int i32x8 __attribute__((ext_vector_type(8)));
typedef int i32x4 __attribute__((ext_vector_type(4)));
typedef int i32x6 __attribute__((ext_vector_type(6)));
typedef int i32x2 __attribute__((ext_vector_type(2)));
typedef unsigned u32x6 __attribute__((ext_vector_type(6)));
typedef float f32x16 __attribute__((ext_vector_type(16)));

constexpr int BATCH = 4, SEQ = 8192, DM = 1024, T = BATCH * SEQ, DIN = 3584, NEXP = 32;
constexpr int NWAVES = 8, NTHR = 512;
constexpr int MT_MAX = 544, PMAX = MT_MAX * 256;
constexpr float NORM_EPS = 1e-5f;
constexpr int NPH = 10;

constexpr size_t MiB = 1u << 20;
constexpr size_t WS_CTL = 0, CTL_BYTES = 1 * MiB;
constexpr size_t WS_ROPE = 1 * MiB;
constexpr size_t WS_WR = 3 * MiB;
constexpr size_t WS_WIN = 5 * MiB, WS_WOUT = 12 * MiB, WS_WGU = 14 * MiB, WS_WDN = 142 * MiB;
constexpr size_t WS_H = 206 * MiB;
constexpr size_t WS_X1 = 270 * MiB;
constexpr size_t WS_C = 398 * MiB;
constexpr size_t WS_D = 670 * MiB;
constexpr size_t WS_KV = WS_D, WS_ST = WS_D + 64 * MiB, WS_OBR = WS_D + 96 * MiB, WS_LSE = WS_D + 192 * MiB;
constexpr size_t WS_RT = 942 * MiB;
constexpr size_t WS_RTOK = WS_RT, WS_RGATE = WS_RT + 4 * MiB, WS_RRSTD = WS_RT + 8 * MiB, WS_SLOT = WS_RT + 12 * MiB;
constexpr size_t WS_END = 956 * MiB;
constexpr int CW_BAR = 4096;
constexpr int CW_CNT = 16384;
constexpr int CW_CONV6 = 24576;
constexpr int CW_CONV = 20480;

constexpr int RING_BYTES = 131072;
constexpr int MISC_OFF = RING_BYTES;
constexpr int LDS_BYTES = 147456;
constexpr int MO_BAR = 0;
constexpr int MO_CNT = 64;
constexpr int MO_TP = 256;
constexpr int MO_TE = 512;
constexpr int MO_HIST = 1280;
constexpr int MO_BASE = 1536;
constexpr int MO_G2 = 4096;
constexpr int MO_ROPEB = 12288;
constexpr int MO_EPI = 8192;

typedef __bf16 bf16x2_t __attribute__((ext_vector_type(2)));
__device__ __forceinline__ unsigned cvt_pk_bf16(float lo, float hi) { const bf16x2_t v = {(__bf16)lo, (__bf16)hi}; return __builtin_bit_cast(unsigned, v); }
__device__ __forceinline__ float bf2f(unsigned short b) { return __uint_as_float(((unsigned)b) << 16); }
__device__ __forceinline__ float bflo(unsigned w) { return __uint_as_float(w << 16); }
__device__ __forceinline__ float bfhi(unsigned w) { return __uint_as_float(w & 0xffff0000u); }
__device__ __forceinline__ float h2f_lo(unsigned w) { return (float)__builtin_bit_cast(_Float16, (unsigned short)(w & 0xffffu)); }
__device__ __forceinline__ float h2f_hi(unsigned w) { return (float)__builtin_bit_cast(_Float16, (unsigned short)(w >> 16)); }
__device__ __forceinline__ float clamp448(float v) { return __builtin_amdgcn_fmed3f(v, -448.0f, 448.0f); }
__device__ __forceinline__ unsigned pk4_fp8(float a, float b, float c, float d) {
    int w = __builtin_amdgcn_cvt_pk_fp8_f32(a, b, 0, false); w = __builtin_amdgcn_cvt_pk_fp8_f32(c, d, w, true); return (unsigned)w; }
constexpr float W6_SCALE = 64.0f, H6_SCALE = 1.5f;
constexpr float W8_SCALE = 64.0f, ACT8_SCALE = 4.0f, YB8_SCALE = 16.0f;
#define LDS_WAIT() asm volatile("s_waitcnt lgkmcnt(0)" ::: "memory")
#define VM_WAIT() asm volatile("s_waitcnt vmcnt(0)" ::: "memory")
__device__ __forceinline__ float wave_sum(float v) {
#pragma unroll
    for (int o = 1; o < 64; o <<= 1) v += __shfl_xor(v, o);
    return v;
}
__device__ __forceinline__ bf16x8 as_bf16x8(u32x4 w) { return *reinterpret_cast<bf16x8*>(&w); }

#define XB_TMO      128
#define XB_XCNT(j)  (256  + 64 * (j))
#define XB_XSUB(j)  (1280 + 64 * (j))
#define XB_XGEN(j)  (2304 + 64 * (j))
#define XB_TOP      3328
#define XB_TOPGEN   3392
#define XCD_BAR_WORDS 3456
#define XB_SPIN_CAP (1u << 18)
__device__ __forceinline__ unsigned xb_ld(unsigned* p)              { return __hip_atomic_load(p, __ATOMIC_RELAXED, __HIP_MEMORY_SCOPE_AGENT); }
__device__ __forceinline__ unsigned xb_add(unsigned* p, unsigned v) { return __hip_atomic_fetch_add(p, v, __ATOMIC_RELAXED, __HIP_MEMORY_SCOPE_AGENT); }
__device__ __forceinline__ unsigned xb_xcc_id() { return (unsigned)__builtin_amdgcn_s_getreg((3 << 11) | 20) & 0xFu; }
#define XB_SPIN(cond, bar) do { unsigned _sp = 0; while (cond) { __builtin_amdgcn_s_sleep(1); \
    if ((++_sp & 255u) == 0u) { if (xb_ld(&(bar)[XB_TMO])) break; if (_sp > XB_SPIN_CAP) { atomicAdd(&(bar)[XB_TMO], 1u); break; } } } } while (0)
struct XcdBarrier { unsigned* bar; unsigned x; volatile LAS unsigned* st; };
__device__ __forceinline__ XcdBarrier xcd_barrier_post(unsigned* bar, volatile LAS unsigned* st) {
    XcdBarrier b; b.bar = bar; b.x = xb_xcc_id(); b.st = st;
    if (threadIdx.x == 0) (void)xb_add(&bar[XB_XCNT(b.x)], 1u);
    return b;
}
__device__ __forceinline__ void xcd_barrier_complete(unsigned* bar, unsigned x, unsigned& nloc, unsigned& nx) {
    const unsigned G = gridDim.x * gridDim.y * gridDim.z;
    unsigned sum, cnt, mine, sp = 0u;
    for (;;) {
        sum = 0u; cnt = 0u; mine = 0u;
#pragma unroll
        for (unsigned j = 0; j < 16; ++j) { const unsigned c = xb_ld(&bar[XB_XCNT(j)]); sum += c; cnt += (c > 0u) ? 1u : 0u; mine = (j == x) ? c : mine; }
        if (sum == G) break;
        __builtin_amdgcn_s_sleep(1);
        if ((++sp & 255u) == 0u) { if (xb_ld(&bar[XB_TMO])) break; if (sp > XB_SPIN_CAP) { atomicAdd(&bar[XB_TMO], 1u); break; } }
    }
    nloc = mine > 0u ? mine : 1u; nx = cnt > 0u ? cnt : 1u;
}
__device__ __forceinline__ void xcd_barrier(const XcdBarrier& b) {
    asm volatile("s_waitcnt vmcnt(0)" ::: "memory");
    __syncthreads();
    if (threadIdx.x == 0) {
        unsigned* bar = b.bar;
        __builtin_amdgcn_s_waitcnt(0);
        unsigned nloc = b.st[0], nx = b.st[1];
        if (nloc == 0u) { xcd_barrier_complete(bar, b.x, nloc, nx); b.st[0] = nloc; b.st[1] = nx; }
        const unsigned old = xb_add(&bar[XB_XSUB(b.x)], 1u);
        const unsigned gen = old / nloc;
        if (old + 1u == (gen + 1u) * nloc) {
            __builtin_amdgcn_fence(__ATOMIC_RELEASE, "agent");
            asm volatile("s_waitcnt vmcnt(0)" ::: "memory");
            const unsigned og = xb_add(&bar[XB_TOP], 1u);
            const unsigned tg = og / nx;
            if (og + 1u == (tg + 1u) * nx) xb_add(&bar[XB_TOPGEN], 1u);
            else XB_SPIN(xb_ld(&bar[XB_TOPGEN]) == tg, bar);
            __builtin_amdgcn_fence(__ATOMIC_ACQUIRE, "agent");
            xb_add(&bar[XB_XGEN(b.x)], 1u);
            asm volatile("s_waitcnt vmcnt(0)" ::: "memory");
        } else {
            XB_SPIN(xb_ld(&bar[XB_XGEN(b.x)]) == gen, bar);
            __builtin_amdgcn_fence(__ATOMIC_ACQUIRE, "agent");
            asm volatile("s_waitcnt vmcnt(0)" ::: "memory");
        }
    }
    __syncthreads();
}

namespace pg8 {
constexpr int BM = 256, BK = 64, HALF = 128, HTB = HALF * BK * 2, NXCD = 8, WGM = 8, KD = 1024, NKT = KD / BK;
__device__ __forceinline__ int lds_byte(int r, int c) { const int st = (r >> 4) * 2 + (c >> 5), rr = r & 15, cc = c & 31, ob = rr * 64 + cc * 2; return st * 1024 + (ob ^ (((ob >> 9) & 1) << 5)); }
__device__ __forceinline__ void stage_rc(int b, int& R, int& C) { const int st = b / 1024, sb = b % 1024, swz = sb ^ (((sb >> 9) & 1) << 5); R = (st >> 1) * 16 + swz / 64; C = (st & 1) * 32 + (swz % 64) / 2; }
__device__ __forceinline__ int perm32(int rho) { const int n = rho >> 4, i = rho & 15; return 8 * (i >> 2) + 4 * n + (i & 3); }

struct StaticOrder {
    int nM, nN, nwg, G, c;
    __device__ void init(int M, int N, int G_, int c_) { nM = M / BM; nN = N / BM; nwg = nM * nN; G = G_; c = c_; }
    __device__ bool next(int i, int& pm, int& pn) const {
        const long L = (long)i * G + c; if (L >= nwg) return false;
        int wgid = (int)L; { const int q = nwg / NXCD, r = nwg % NXCD, xcd = wgid % NXCD, off = wgid / NXCD; wgid = (xcd < r ? xcd * (q + 1) : r * (q + 1) + (xcd - r) * q) + off; }
        const int nig = WGM * nN, gid = wgid / nig, fm = gid * WGM, gsz = (nM - fm) < WGM ? (nM - fm) : WGM;
        pm = fm + ((wgid % nig) % gsz); pn = (wgid % nig) / gsz; return true;
    }
};

template <bool SIX> struct FragOf { typedef i32x8 type; };
template <> struct FragOf<true> { typedef i32x6 type; };
template <int H> __device__ __forceinline__ bf16x8 half8(i32x8 v) { const i32x4 h = H ? __builtin_shufflevector(v, v, 4, 5, 6, 7) : __builtin_shufflevector(v, v, 0, 1, 2, 3); return *reinterpret_cast<const bf16x8*>(&h); }
template <class P, bool NOEPI = false>
__device__ __forceinline__ void gemm_phase(LAS unsigned char* lds, const P& S) {
    typedef typename P::U Unit;
    const int tid = threadIdx.x, wid = __builtin_amdgcn_readfirstlane(tid >> 6), lane = tid & 63, wr = wid >> 2, wc = wid & 3, fr = lane & 15, fq = lane >> 4;
    constexpr bool ZI = P::ZINIT;
    constexpr bool F8 = P::FP8, F6 = P::FP6;
    constexpr int PB = F8 ? 1024 : 2048, nt = F8 ? 8 : 16;
    int R0, C0, R1, C1; stage_rc(tid * 16, R0, C0); stage_rc(tid * 16 + 8192, R1, C1);
    unsigned voffB[2];
    { const int Rb0 = P::PERM ? ((R0 & ~31) + perm32(R0 & 31)) : R0, Rb1 = P::PERM ? ((R1 & ~31) + perm32(R1 & 31)) : R1;
      voffB[0] = (unsigned)(Rb0 * PB + C0 * 2); voffB[1] = (unsigned)(Rb1 * PB + C1 * 2); }
    constexpr size_t kstep = (size_t)(BK * 2);
    constexpr size_t hstep = (size_t)HALF * PB;
    const unsigned ldsw = (unsigned)wid * 1024u;
    const int aoff = lds_byte(wr * 64 + fr, fq * 8), boff = lds_byte(wc * 32 + fr, fq * 8);
#define PG8_SA(b, h) (((b) * 2 + (h)) * HTB)
#define PG8_SB(b, h) ((4 + (b) * 2 + (h)) * HTB)
#define PG8_STAGE(bufoff, gbase, voff) do { _Pragma("unroll") for (int _i = 0; _i < 2; ++_i) \
        __builtin_amdgcn_global_load_lds((const unsigned*)((const char*)(gbase) + (voff)[_i]), (LAS unsigned*)(lds + (bufoff) + ldsw + _i * 8192), 16, 0, 0); } while (0)
#define PG8_LDA(dst, b, h) do { _Pragma("unroll") for (int m = 0; m < 4; ++m) { const i32x4 _lo = *(const LAS i32x4*)(lds + PG8_SA(b, h) + aoff + m * 2048); \
        if constexpr (F6) { const i32x2 _h2 = *(const volatile LAS i32x2*)(lds + PG8_SA(b, h) + aoff + m * 2048 + 1024); const i32x4 _hi = __builtin_shufflevector(_h2, _h2, 0, 1, -1, -1); dst[m] = __builtin_shufflevector(_lo, _hi, 0, 1, 2, 3, 4, 5); } \
        else { const i32x4 _hi = *(const LAS i32x4*)(lds + PG8_SA(b, h) + aoff + m * 2048 + 1024); dst[m] = __builtin_shufflevector(_lo, _hi, 0, 1, 2, 3, 4, 5, 6, 7); } } } while (0)
#define PG8_LDB(dst, b, h) do { _Pragma("unroll") for (int n = 0; n < 2; ++n) { const i32x4 _lo = *(const LAS i32x4*)(lds + PG8_SB(b, h) + boff + n * 2048); \
        if constexpr (F6) { const i32x2 _h2 = *(const volatile LAS i32x2*)(lds + PG8_SB(b, h) + boff + n * 2048 + 1024); const i32x4 _hi = __builtin_shufflevector(_h2, _h2, 0, 1, -1, -1); dst[n] = __builtin_shufflevector(_lo, _hi, 0, 1, 2, 3, 4, 5); } \
        else { const i32x4 _hi = *(const LAS i32x4*)(lds + PG8_SB(b, h) + boff + n * 2048 + 1024); dst[n] = __builtin_shufflevector(_lo, _hi, 0, 1, 2, 3, 4, 5, 6, 7); } } } while (0)
#define PG8_MMA(ai, bj, At, Bt) do { __builtin_amdgcn_s_setprio(1); _Pragma("unroll") for (int m = 0; m < 4; ++m) _Pragma("unroll") for (int n = 0; n < 2; ++n) { \
        if constexpr (F6) { asm volatile("v_mfma_f32_16x16x128_f8f6f4 %0, %1, %2, %0 cbsz:2 blgp:2" : "+v"(acc[ai][bj][m][n]) : "v"(Bt[n]), "v"(At[m])); } \
        else if constexpr (F8) { asm volatile("v_mfma_f32_16x16x128_f8f6f4 %0, %1, %2, %0" : "+v"(acc[ai][bj][m][n]) : "v"(Bt[n]), "v"(At[m])); } \
        else { acc[ai][bj][m][n] = __builtin_amdgcn_mfma_f32_16x16x32_bf16(half8<0>(Bt[n]), half8<0>(At[m]), acc[ai][bj][m][n], 0, 0, 0); \
               acc[ai][bj][m][n] = __builtin_amdgcn_mfma_f32_16x16x32_bf16(half8<1>(Bt[n]), half8<1>(At[m]), acc[ai][bj][m][n], 0, 0, 0); } } \
        __builtin_amdgcn_s_setprio(0); } while (0)
#define PG8_MMA0(ai, bj, At, Bt) do { __builtin_amdgcn_s_setprio(1); _Pragma("unroll") for (int m = 0; m < 4; ++m) _Pragma("unroll") for (int n = 0; n < 2; ++n) { \
        if constexpr (F6) { asm volatile("v_mfma_f32_16x16x128_f8f6f4 %0, %1, %2, 0 cbsz:2 blgp:2" : "=&v"(acc[ai][bj][m][n]) : "v"(Bt[n]), "v"(At[m])); } \
        else if constexpr (F8) { asm volatile("v_mfma_f32_16x16x128_f8f6f4 %0, %1, %2, 0" : "=&v"(acc[ai][bj][m][n]) : "v"(Bt[n]), "v"(At[m])); } \
        else { acc[ai][bj][m][n] = __builtin_amdgcn_mfma_f32_16x16x32_bf16(half8<0>(Bt[n]), half8<0>(At[m]), (f32x4){0.f, 0.f, 0.f, 0.f}, 0, 0, 0); \
               acc[ai][bj][m][n] = __builtin_amdgcn_mfma_f32_16x16x32_bf16(half8<1>(Bt[n]), half8<1>(At[m]), acc[ai][bj][m][n], 0, 0, 0); } } \
        __builtin_amdgcn_s_setprio(0); } while (0)
#define PG8_MMAF(ai, bj, At, Bt) do { if (ZI && t == 0) PG8_MMA0(ai, bj, At, Bt); else PG8_MMA(ai, bj, At, Bt); } while (0)
#define PG8_INIT(u_) do { if constexpr (ZI) { _Pragma("unroll") for (int a_ = 0; a_ < 2; ++a_) _Pragma("unroll") for (int b_ = 0; b_ < 2; ++b_) _Pragma("unroll") for (int m_ = 0; m_ < 4; ++m_) _Pragma("unroll") for (int n_ = 0; n_ < 2; ++n_) \
        asm volatile("" : "=v"(acc[a_][b_][m_][n_])); } else S.init_acc(acc, u_, wr, wc, fr, fq); } while (0)
#define PG8_WAIT_V(n) asm volatile("s_waitcnt vmcnt(" #n ")" ::: "memory")
#define PG8_WAIT_L(n) asm volatile("s_waitcnt lgkmcnt(" #n ")" ::: "memory")
#define PG8_BAR __builtin_amdgcn_s_barrier()
#define PG8_SCHED __builtin_amdgcn_sched_barrier(0)
    Unit cur, nxt; int ui = 0;
    if (!S.next(0, cur)) return;
    f32x4 acc[2][2][4][2];
    PG8_INIT(cur);
    typename FragOf<F6>::type At[4], B0[2], B1[2];
    unsigned vc[2][2], vn[2][2];
    S.a_off(cur, R0, C0, R1, C1, vc);
    const char* const Ab = S.a_base();
    const char* cB = S.b_ptr(cur);
    S.pre_unit(cur, 0, wid, lane);
    PG8_STAGE(PG8_SB(0, 0), cB, voffB); PG8_STAGE(PG8_SA(0, 0), Ab, vc[0]); PG8_STAGE(PG8_SB(0, 1), cB + hstep, voffB); PG8_STAGE(PG8_SA(0, 1), Ab, vc[1]);
    if (wr == 1) PG8_BAR;
    if constexpr (F8) PG8_WAIT_V(2); else PG8_WAIT_V(4);
    PG8_BAR;
    PG8_STAGE(PG8_SB(1, 0), cB + kstep, voffB); PG8_STAGE(PG8_SA(1, 0), Ab + kstep, vc[0]); PG8_STAGE(PG8_SB(1, 1), cB + hstep + kstep, voffB);
    PG8_WAIT_V(6); PG8_BAR;
    for (;;) {
        const bool has_next = S.next(ui + 1, nxt);
        const char* nB = cB;
        if (has_next) { S.a_off(nxt, R0, C0, R1, C1, vn); nB = S.b_ptr(nxt); }
        else {
#pragma unroll
            for (int h = 0; h < 2; ++h)
#pragma unroll
                for (int i = 0; i < 2; ++i) vn[h][i] = vc[h][i]; }
#pragma unroll 1
        for (int t = 0; t < nt; t += 2) {
            const bool last = (t == nt - 2);
            const char* a1 = Ab + (size_t)(t + 1) * kstep;
            const char* a2 = last ? Ab : Ab + (size_t)(t + 2) * kstep; const char* b2 = last ? nB : cB + (size_t)(t + 2) * kstep;
            const char* a3 = a2 + kstep; const char* b3 = b2 + kstep;
            unsigned vs[2][2];
#pragma unroll
            for (int h = 0; h < 2; ++h)
#pragma unroll
                for (int i = 0; i < 2; ++i) vs[h][i] = last ? vn[h][i] : vc[h][i];
            if constexpr (F8) {
                PG8_LDB(B0, 0, 0); PG8_LDB(B1, 0, 1); PG8_SCHED; PG8_LDA(At, 0, 0); PG8_STAGE(PG8_SA(1, 1), a1, vc[1]);
                PG8_WAIT_V(8); PG8_WAIT_L(0); PG8_BAR; PG8_MMAF(0, 0, At, B0); PG8_MMAF(0, 1, At, B1); PG8_BAR; PG8_SCHED;
                PG8_LDA(At, 0, 1); PG8_STAGE(PG8_SB(0, 0), b2, voffB); PG8_STAGE(PG8_SA(0, 0), a2, vs[0]); PG8_STAGE(PG8_SB(0, 1), b2 + hstep, voffB);
                PG8_WAIT_V(8); PG8_WAIT_L(0); PG8_BAR; PG8_MMAF(1, 0, At, B0); PG8_MMAF(1, 1, At, B1); PG8_BAR; PG8_SCHED;
                PG8_LDB(B0, 1, 0); PG8_LDB(B1, 1, 1); PG8_SCHED; PG8_LDA(At, 1, 0); PG8_STAGE(PG8_SA(0, 1), a2, vs[1]);
                PG8_WAIT_V(8); PG8_WAIT_L(0); PG8_BAR; PG8_MMA(0, 0, At, B0); PG8_MMA(0, 1, At, B1); PG8_BAR; PG8_SCHED;
                PG8_LDA(At, 1, 1); PG8_STAGE(PG8_SB(1, 0), b3, voffB); PG8_STAGE(PG8_SA(1, 0), a3, vs[0]); PG8_STAGE(PG8_SB(1, 1), b3 + hstep, voffB);
                PG8_WAIT_V(8); PG8_WAIT_L(0); PG8_BAR; PG8_MMA(1, 0, At, B0); PG8_MMA(1, 1, At, B1); PG8_BAR;
            } else {
                PG8_LDB(B0, 0, 0); PG8_SCHED; PG8_LDA(At, 0, 0); PG8_STAGE(PG8_SA(1, 1), a1, vc[1]);
                PG8_WAIT_L(8); PG8_BAR; PG8_WAIT_L(0); PG8_MMAF(0, 0, At, B0); PG8_BAR; PG8_SCHED;
                PG8_LDB(B1, 0, 1); PG8_STAGE(PG8_SB(0, 0), b2, voffB);
                PG8_BAR; PG8_WAIT_L(0); PG8_MMAF(0, 1, At, B1); PG8_BAR;
                PG8_LDA(At, 0, 1); PG8_STAGE(PG8_SA(0, 0), a2, vs[0]);
                PG8_BAR; PG8_WAIT_L(0); PG8_MMAF(1, 0, At, B0); PG8_BAR; PG8_SCHED;
                PG8_STAGE(PG8_SB(0, 1), b2 + hstep, voffB);
                PG8_WAIT_V(6); PG8_BAR; PG8_MMAF(1, 1, At, B1); PG8_BAR;
                PG8_LDB(B0, 1, 0); PG8_SCHED; PG8_LDA(At, 1, 0); PG8_STAGE(PG8_SA(0, 1), a2, vs[1]);
                PG8_WAIT_L(8); PG8_BAR; PG8_WAIT_L(0); PG8_MMA(0, 0, At, B0); PG8_BAR; PG8_SCHED;
                PG8_LDB(B1, 1, 1); PG8_STAGE(PG8_SB(1, 0), b3, voffB);
                PG8_BAR; PG8_WAIT_L(0); PG8_MMA(0, 1, At, B1); PG8_BAR;
                PG8_LDA(At, 1, 1); PG8_STAGE(PG8_SA(1, 0), a3, vs[0]);
                PG8_BAR; PG8_WAIT_L(0); PG8_MMA(1, 0, At, B0); PG8_BAR; PG8_SCHED;
                PG8_STAGE(PG8_SB(1, 1), b3 + hstep, voffB);
                PG8_WAIT_V(6); PG8_BAR; PG8_MMA(1, 1, At, B1); PG8_BAR;
            }
        }
        if constexpr (F8) asm volatile("s_nop 15\n\ts_nop 15" ::: "memory");
        if constexpr (!NOEPI) S.epi(acc, cur, wr, wc, fr, fq, ui & 1);
        else {
#pragma unroll
            for (int a = 0; a < 2; ++a)
#pragma unroll
                for (int b = 0; b < 2; ++b)
#pragma unroll
                    for (int m = 0; m < 4; ++m)
#pragma unroll
                        for (int n = 0; n < 2; ++n) asm volatile("" :: "v"(acc[a][b][m][n]));
        }
        if (!has_next) break;
        PG8_INIT(nxt);
        cur = nxt; cB = nB; ++ui;
        S.pre_unit(cur, ui & 1, wid, lane);
#pragma unroll
        for (int h = 0; h < 2; ++h)
#pragma unroll
            for (int i = 0; i < 2; ++i) vc[h][i] = vn[h][i];
    }
    PG8_WAIT_V(0);
    if (wr == 0) PG8_BAR;
    PG8_BAR;
#undef PG8_SA
#undef PG8_SB
#undef PG8_STAGE
#undef PG8_LDA
#undef PG8_LDB
#undef PG8_MMA
#undef PG8_MMA0
#undef PG8_MMAF
#undef PG8_INIT
#undef PG8_WAIT_V
#undef PG8_WAIT_L
#undef PG8_BAR
#undef PG8_SCHED
}
}

struct Frame {
    LAS unsigned char* lds;
    int tid, lane, wave, G, vcu;
    const float *x, *norm_mix_g, *w_in, *w_out, *norm_ffn_g, *w_router, *b_router, *w_gu, *b_gu, *w_dn, *b_dn, *norm_final_g;
    float* out; unsigned char* ws; unsigned* ctl;
};
struct Args { const float* in[12]; float* out; unsigned char* ws; int ph_lo, ph_hi; };

__device__ __forceinline__ void zero_acc(f32x4 (&acc)[2][2][4][2]) {
#pragma unroll
    for (int a = 0; a < 2; ++a)
#pragma unroll
        for (int b = 0; b < 2; ++b)
#pragma unroll
            for (int m = 0; m < 4; ++m)
#pragma unroll
                for (int n = 0; n < 2; ++n) acc[a][b][m][n] = (f32x4){0.f, 0.f, 0.f, 0.f};
}
template <int PB = 2048>
__device__ __forceinline__ void dense_a_off(int row0, int R0, int C0, int R1, int C1, unsigned (&vo)[2][2]) {
#pragma unroll
    for (int h = 0; h < 2; ++h) { vo[h][0] = (unsigned)((row0 + 128 * h + R0) * PB + C0 * 2); vo[h][1] = (unsigned)((row0 + 128 * h + R1) * PB + C1 * 2); }
}

struct Cx8 { f32x4 c0, c1, s0, s1; };
__device__ __forceinline__ Cx8 cx8_lds(const LAS unsigned* p) {
    const u32x4 t0 = *(const LAS u32x4*)p, t1 = *(const LAS u32x4*)(p + 4); Cx8 r;
#pragma unroll
    for (int j = 0; j < 4; ++j) { r.c0[j] = h2f_lo(t0[j]); r.s0[j] = h2f_hi(t0[j]); r.c1[j] = h2f_lo(t1[j]); r.s1[j] = h2f_hi(t1[j]); }
    return r;
}
__device__ __forceinline__ Cx8 cx8_mul(const Cx8& a, const Cx8& b) {
    Cx8 r; r.c0 = a.c0 * b.c0 - a.s0 * b.s0; r.s0 = a.c0 * b.s0 + a.s0 * b.c0; r.c1 = a.c1 * b.c1 - a.s1 * b.s1; r.s1 = a.c1 * b.s1 + a.s1 * b.c1; return r;
}
struct ProjProb {
    struct U { int pm, pn; };
    static constexpr bool PERM = true, FP8 = false, FP6 = false, ZINIT = true;
    pg8::StaticOrder so; const char* A; const char* Bt; bf16_t* dst; const unsigned* rt; const LAS unsigned char* misc; int i0 = 0, i1 = 1 << 30;
    __device__ __forceinline__ bool next(int i, U& u) const { i += i0; if (i >= i1) return false; return so.next(i, u.pm, u.pn); }
    __device__ __forceinline__ void a_off(const U& u, int R0, int C0, int R1, int C1, unsigned (&vo)[2][2]) const { dense_a_off(u.pm * 256, R0, C0, R1, C1, vo); }
    __device__ __forceinline__ const char* a_base() const { return A; }
    __device__ __forceinline__ const char* b_ptr(const U& u) const { return Bt + (size_t)u.pn * (256 * 1024 * 2); }
    __device__ __forceinline__ void init_acc(f32x4 (&acc)[2][2][4][2], const U&, int, int, int, int) const { zero_acc(acc); }
    __device__ __forceinline__ void pre_unit(const U& u, int par, int wid, int lane) const {
        __builtin_amdgcn_global_load_lds(rt + (size_t)((u.pm * 256) & 8191) * 64 + lane, (LAS unsigned*)((LAS unsigned char*)misc + MO_EPI + par * 2048 + wid * 256), 4, 0, 0);
    }
    __device__ __forceinline__ void epi(const f32x4 (&acc)[2][2][4][2], const U& u, int wr, int wc, int fr, int fq, int par) const {
        const int kind = u.pn >> 1, hp = (u.pn & 1) * 2;
        bf16_t* base = dst + (size_t)kind * ((size_t)T * 512);
        const bool rot = (kind == 0) || (kind == 1) || (kind == 4) || (kind == 5);
        const float scale = (kind == 1 || kind == 4) ? 0.08838834764831845f : 1.0f;
        if (rot) {
            const int i0 = (wc & 1) * 32 + 8 * fq, h = hp + (wc >> 1);
            const LAS unsigned* TA = (const LAS unsigned*)(misc + MO_G2); const LAS unsigned* TB = (const LAS unsigned*)(misc + MO_ROPEB);
            const LAS unsigned* EP = (const LAS unsigned*)(misc + MO_EPI + par * 2048 + (wr * 4 + wc) * 256);
            Cx8 E0 = cx8_mul(cx8_mul(cx8_lds(EP + i0), cx8_lds(TB + (4 * wr) * 64 + i0)), cx8_lds(TA + fr * 64 + i0));
            E0.c0 *= scale; E0.c1 *= scale; E0.s0 *= scale; E0.s1 *= scale;
#pragma unroll
            for (int ai = 0; ai < 2; ++ai)
#pragma unroll
                for (int m = 0; m < 4; ++m) {
                    const int row = u.pm * 256 + ai * 128 + wr * 64 + m * 16 + fr, b = row >> 13, s = row & 8191;
                    const Cx8 E = cx8_mul(E0, cx8_lds(TB + (ai * 8 + m) * 64 + i0));
                    const f32x4 c0 = E.c0, c1 = E.c1, s0 = E.s0, s1 = E.s1;
                    const f32x4 a0 = acc[ai][0][m][0], a1 = acc[ai][0][m][1], b0 = acc[ai][1][m][0], b1 = acc[ai][1][m][1];
                    const f32x4 o10 = a0 * c0 - b0 * s0, o11 = a1 * c1 - b1 * s1;
                    const f32x4 o20 = a0 * s0 + b0 * c0, o21 = a1 * s1 + b1 * c1;
                    bf16_t* p = base + ((size_t)((b * 4 + h) * 8192 + s)) * 128 + i0;
                    u32x4 w1 = {cvt_pk_bf16(o10[0], o10[1]), cvt_pk_bf16(o10[2], o10[3]), cvt_pk_bf16(o11[0], o11[1]), cvt_pk_bf16(o11[2], o11[3])};
                    u32x4 w2 = {cvt_pk_bf16(o20[0], o20[1]), cvt_pk_bf16(o20[2], o20[3]), cvt_pk_bf16(o21[0], o21[1]), cvt_pk_bf16(o21[2], o21[3])};
                    *(u32x4*)p = w1; *(u32x4*)(p + 64) = w2;
                }
        } else {
            const int col = wc * 32 + 8 * fq;
#pragma unroll
            for (int ai = 0; ai < 2; ++ai)
#pragma unroll
                for (int m = 0; m < 4; ++m) {
                    const int row = u.pm * 256 + ai * 128 + wr * 64 + m * 16 + fr, b = row >> 13, s = row & 8191;
#pragma unroll
                    for (int bj = 0; bj < 2; ++bj) {
                        f32x4 v0 = acc[ai][bj][m][0], v1 = acc[ai][bj][m][1];
                        if (kind == 3) {
#pragma unroll
                            for (int j = 0; j < 4; ++j) { v0[j] = v0[j] * __builtin_amdgcn_rcpf(1.0f + __expf(-v0[j])); v1[j] = v1[j] * __builtin_amdgcn_rcpf(1.0f + __expf(-v1[j])); }
                        }
                        u32x4 w = {cvt_pk_bf16(v0[0], v0[1]), cvt_pk_bf16(v0[2], v0[3]), cvt_pk_bf16(v1[0], v1[1]), cvt_pk_bf16(v1[2], v1[3])};
                        *(u32x4*)(base + ((size_t)((b * 4 + hp + bj) * 8192 + s)) * 128 + col) = w;
                    }
                }
        }
    }
};

struct OutProb {
    struct U { int pm, pn; };
    static constexpr bool PERM = true, FP8 = false, FP6 = false, ZINIT = false;
    pg8::StaticOrder so; const char* A; const char* Bt; const float* x; bf16_t* x1;
    __device__ __forceinline__ bool next(int i, U& u) const { return so.next(i, u.pm, u.pn); }
    __device__ __forceinline__ void a_off(const U& u, int R0, int C0, int R1, int C1, unsigned (&vo)[2][2]) const { dense_a_off(u.pm * 256, R0, C0, R1, C1, vo); }
    __device__ __forceinline__ const char* a_base() const { return A; }
    __device__ __forceinline__ const char* b_ptr(const U& u) const { return Bt + (size_t)u.pn * (256 * 1024 * 2); }
    __device__ __forceinline__ void init_acc(f32x4 (&acc)[2][2][4][2], const U& u, int wr, int wc, int fr, int fq) const {
        const int row0 = u.pm * 256 + wr * 64 + fr, col0 = u.pn * 256 + wc * 32 + 8 * fq;
#pragma unroll
        for (int ai = 0; ai < 2; ++ai)
#pragma unroll
            for (int m = 0; m < 4; ++m) {
                const size_t off = (size_t)(row0 + ai * 128 + m * 16) * 1024 + col0;
#pragma unroll
                for (int bj = 0; bj < 2; ++bj)
#pragma unroll
                    for (int n = 0; n < 2; ++n) acc[ai][bj][m][n] = __builtin_nontemporal_load((const f32x4*)(x + off + bj * 128 + n * 4));
            }
    }
    __device__ __forceinline__ void pre_unit(const U&, int, int, int) const {}
    __device__ __forceinline__ void epi(const f32x4 (&acc)[2][2][4][2], const U& u, int wr, int wc, int fr, int fq, int) const {
        const int row0 = u.pm * 256 + wr * 64 + fr, col0 = u.pn * 256 + wc * 32 + 8 * fq;
#pragma unroll
        for (int ai = 0; ai < 2; ++ai)
#pragma unroll
            for (int m = 0; m < 4; ++m) {
                const size_t off = (size_t)(row0 + ai * 128 + m * 16) * 1024 + col0;
#pragma unroll
                for (int bj = 0; bj < 2; ++bj) { const f32x4 v0 = acc[ai][bj][m][0], v1 = acc[ai][bj][m][1];
                    u32x4 w = {cvt_pk_bf16(v0[0], v0[1]), cvt_pk_bf16(v0[2], v0[3]), cvt_pk_bf16(v1[0], v1[1]), cvt_pk_bf16(v1[2], v1[3])};
                    *(u32x4*)(x1 + off + bj * 128) = w; }
            }
    }
};

struct MoeU { int mt, pn, e, ml, cnt; };
template <int NNT>
__device__ __forceinline__ bool moe_next(const LAS unsigned char* misc, int i, int G, int vcu, MoeU& u) {
    const LAS int* tp = (const LAS int*)(misc + MO_TP);
    const int TM = tp[32], total = TM * NNT;
    const int L = i * G + vcu; if (L >= total) return false;
    const int full = TM / 8, grp = L / (8 * NNT);
    int mt, pn;
    if (grp < full) { mt = grp * 8 + (L % 8); pn = (L / 8) % NNT; }
    else { const int rem = L - full * 8 * NNT, gsz = TM - full * 8; mt = full * 8 + rem % gsz; pn = rem / gsz; }
    const int e = ((const LAS unsigned char*)(misc + MO_TE))[mt];
    u.mt = __builtin_amdgcn_readfirstlane(mt); u.pn = __builtin_amdgcn_readfirstlane(pn); u.e = __builtin_amdgcn_readfirstlane(e);
    u.ml = u.mt - __builtin_amdgcn_readfirstlane(tp[e]); u.cnt = __builtin_amdgcn_readfirstlane(((const LAS int*)(misc + MO_CNT))[e]);
    return true;
}
__device__ __forceinline__ void moe_tables(Frame& F) {
    LAS unsigned char* misc = F.lds + MISC_OFF;
    LAS int* cnt = (LAS int*)(misc + MO_CNT); LAS int* tp = (LAS int*)(misc + MO_TP); LAS unsigned char* te = (LAS unsigned char*)(misc + MO_TE);
    __syncthreads();
    if (F.tid < 32) cnt[F.tid] = (int)__hip_atomic_load(F.ctl + CW_CNT + 64 * F.tid, __ATOMIC_RELAXED, __HIP_MEMORY_SCOPE_AGENT);
    __syncthreads();
    if (F.tid == 0) { int s = 0; for (int e = 0; e < 32; ++e) { tp[e] = s; s += (cnt[e] + 255) >> 8; } tp[32] = s; }
    __syncthreads();
    if (F.tid < 32) { const int a = tp[F.tid], b = tp[F.tid + 1]; for (int t = a; t < b; ++t) te[t] = (unsigned char)F.tid; }
    __syncthreads();
}
struct GuProb {
    typedef MoeU U;
    static constexpr bool PERM = true, FP8 = true, FP6 = true, ZINIT = true;
    const LAS unsigned char* misc; int G, vcu;
    const char* A; const char* Bt; const int* rtok; const float* rrstd; const float* bias; unsigned char* act;
    __device__ __forceinline__ bool next(int i, U& u) const { return moe_next<8>(misc, i, G, vcu, u); }
    __device__ __forceinline__ void a_off(const U& u, int R0, int C0, int R1, int C1, unsigned (&vo)[2][2]) const {
        const int* rt = rtok + (size_t)u.e * T; const int rb = u.ml * 256, last = u.cnt - 1;
#pragma unroll
        for (int h = 0; h < 2; ++h) {
            const int r0 = min(rb + 128 * h + R0, last), r1 = min(rb + 128 * h + R1, last);
            const int t0 = rt[r0], t1 = rt[r1];
            vo[h][0] = (unsigned)(t0 * 1024 + C0 * 2); vo[h][1] = (unsigned)(t1 * 1024 + C1 * 2);
        }
    }
    __device__ __forceinline__ const char* a_base() const { return A; }
    __device__ __forceinline__ const char* b_ptr(const U& u) const { return Bt + ((size_t)u.e * 2048 + (size_t)u.pn * 256) * 1024; }
    __device__ __forceinline__ void init_acc(f32x4 (&acc)[2][2][4][2], const U&, int, int, int, int) const { zero_acc(acc); }
    __device__ __forceinline__ void pre_unit(const U& u, int par, int wid, int lane) const {
        const int idx = wid * 64 + lane;
        const float* src = (idx < 256) ? bias + (size_t)u.e * 2048 + (idx >> 7) * 1024 + u.pn * 128 + (idx & 127)
                                       : rrstd + (size_t)u.e * T + min(u.ml * 256 + (idx - 256), u.cnt - 1);
        __builtin_amdgcn_global_load_lds((const unsigned*)src, (LAS unsigned*)((LAS unsigned char*)misc + MO_EPI + par * 2048 + wid * 256), 4, 0, 0);
    }
    __device__ __forceinline__ void epi(const f32x4 (&acc)[2][2][4][2], const U& u, int wr, int wc, int fr, int fq, int par) const {
        const int cl = wc * 32 + 8 * fq;
        const LAS float* ev = (const LAS float*)(misc + MO_EPI + par * 2048);
        const f32x4 bg0 = *(const LAS f32x4*)(ev + cl), bg1 = *(const LAS f32x4*)(ev + cl + 4), bl0 = *(const LAS f32x4*)(ev + 128 + cl), bl1 = *(const LAS f32x4*)(ev + 128 + cl + 4);
        float rsv[2][4];
#pragma unroll
        for (int ai = 0; ai < 2; ++ai)
#pragma unroll
            for (int m = 0; m < 4; ++m) rsv[ai][m] = ev[256 + ai * 128 + wr * 64 + m * 16 + fr];
        asm volatile("" ::: "memory");
#pragma unroll
        for (int ai = 0; ai < 2; ++ai)
#pragma unroll
            for (int m = 0; m < 4; ++m) {
                const int r = ai * 128 + wr * 64 + m * 16 + fr;
                const float rstd = rsv[ai][m] * (1.0f / (W6_SCALE * H6_SCALE));
                const f32x2 rs2 = {rstd, rstd};
                int wq[2] = {0, 0};
#pragma unroll
                for (int hq = 0; hq < 4; ++hq) {
                    const int n = hq >> 1, p = 2 * (hq & 1);
                    const f32x4 av = acc[ai][0][m][n], bvv = acc[ai][1][m][n], bgv = n ? bg1 : bg0, blv = n ? bl1 : bl0;
                    const f32x2 a2 = {av[p], av[p + 1]}, b2 = {bvv[p], bvv[p + 1]}, bg2 = {bgv[p], bgv[p + 1]}, bl2 = {blv[p], blv[p + 1]};
                    f32x2 g2 = __builtin_elementwise_fma(a2, rs2, bg2), l2 = __builtin_elementwise_fma(b2, rs2, bl2);
                    g2[0] = fminf(g2[0], 7.0f); g2[1] = fminf(g2[1], 7.0f);
                    l2[0] = __builtin_amdgcn_fmed3f(l2[0], -7.0f, 7.0f); l2[1] = __builtin_amdgcn_fmed3f(l2[1], -7.0f, 7.0f);
                    const f32x2 t2 = g2 * (f32x2){-2.4554669595930157f, -2.4554669595930157f};
                    f32x2 e2 = {__builtin_amdgcn_exp2f(t2[0]), __builtin_amdgcn_exp2f(t2[1])};
                    e2 = e2 + (f32x2){1.0f, 1.0f};
                    const f32x2 r2 = {__builtin_amdgcn_rcpf(e2[0]), __builtin_amdgcn_rcpf(e2[1])};
                    const f32x2 u2 = __builtin_elementwise_fma(l2, (f32x2){ACT8_SCALE, ACT8_SCALE}, (f32x2){ACT8_SCALE, ACT8_SCALE});
                    const f32x2 o2 = (g2 * r2) * u2;
                    wq[hq >> 1] = (hq & 1) ? __builtin_amdgcn_cvt_pk_fp8_f32(o2[0], o2[1], wq[hq >> 1], true) : __builtin_amdgcn_cvt_pk_fp8_f32(o2[0], o2[1], wq[hq >> 1], false);
                }
                u32x2 w = {(unsigned)wq[0], (unsigned)wq[1]};
                *(u32x2*)(act + (size_t)(u.mt * 256 + r) * 1024 + u.pn * 128 + cl) = w;
            }
    }
};
struct DnProb {
    typedef MoeU U;
    static constexpr bool PERM = true, FP8 = true, FP6 = false, ZINIT = true;
    const LAS unsigned char* misc; int G, vcu;
    const char* A; const char* Bt; const float* rgate; const float* bias; unsigned char* yb;
    __device__ __forceinline__ bool next(int i, U& u) const { return moe_next<4>(misc, i, G, vcu, u); }
    __device__ __forceinline__ void a_off(const U& u, int R0, int C0, int R1, int C1, unsigned (&vo)[2][2]) const { dense_a_off<1024>(u.mt * 256, R0, C0, R1, C1, vo); }
    __device__ __forceinline__ const char* a_base() const { return A; }
    __device__ __forceinline__ const char* b_ptr(const U& u) const { return Bt + ((size_t)u.e * 1024 + (size_t)u.pn * 256) * 1024; }
    __device__ __forceinline__ void init_acc(f32x4 (&acc)[2][2][4][2], const U&, int, int, int, int) const { zero_acc(acc); }
    __device__ __forceinline__ void pre_unit(const U& u, int par, int wid, int lane) const {
        const int idx = wid * 64 + lane;
        const float* src = (idx < 256) ? bias + (size_t)u.e * 1024 + u.pn * 256 + idx : rgate + (size_t)u.e * T + min(u.ml * 256 + (idx - 256), u.cnt - 1);
        __builtin_amdgcn_global_load_lds((const unsigned*)src, (LAS unsigned*)((LAS unsigned char*)misc + MO_EPI + par * 2048 + wid * 256), 4, 0, 0);
    }
    __device__ __forceinline__ void epi(const f32x4 (&acc)[2][2][4][2], const U& u, int wr, int wc, int fr, int fq, int par) const {
        const int cb = wc * 64 + fq * 16;
        const LAS float* ev = (const LAS float*)(misc + MO_EPI + par * 2048);
        f32x4 bv[2][2];
#pragma unroll
        for (int bj = 0; bj < 2; ++bj) { bv[bj][0] = *(const LAS f32x4*)(ev + cb + bj * 8); bv[bj][1] = *(const LAS f32x4*)(ev + cb + bj * 8 + 4); }
        float gtv[2][4];
#pragma unroll
        for (int ai = 0; ai < 2; ++ai)
#pragma unroll
            for (int m = 0; m < 4; ++m) gtv[ai][m] = ev[256 + ai * 128 + wr * 64 + m * 16 + fr];
        asm volatile("" ::: "memory");
#pragma unroll
        for (int ai = 0; ai < 2; ++ai)
#pragma unroll
            for (int m = 0; m < 4; ++m) {
                const int r = ai * 128 + wr * 64 + m * 16 + fr;
                const float gate = gtv[ai][m] * YB8_SCALE;
                u32x4 w;
#pragma unroll
                for (int bj = 0; bj < 2; ++bj) {
                    const f32x4 v0 = (acc[ai][bj][m][0] * (1.0f / (W8_SCALE * ACT8_SCALE)) + bv[bj][0]) * gate, v1 = (acc[ai][bj][m][1] * (1.0f / (W8_SCALE * ACT8_SCALE)) + bv[bj][1]) * gate;
                    w[2 * bj] = pk4_fp8(clamp448(v0[0]), clamp448(v0[1]), clamp448(v0[2]), clamp448(v0[3])); w[2 * bj + 1] = pk4_fp8(clamp448(v1[0]), clamp448(v1[1]), clamp448(v1[2]), clamp448(v1[3]));
                }
                *(u32x4*)(yb + (size_t)(u.mt * 256 + r) * 1024 + u.pn * 256 + cb) = w;
            }
    }
};

__device__ __forceinline__ void tr_item(const float* __restrict__ src, int ldn, int k0, int n0, bf16_t* dst, int drow0, LAS unsigned char* scr, int lane) {
    const int l15 = lane & 15, g = lane >> 4;
    f32x4 v[16];
#pragma unroll
    for (int i = 0; i < 16; ++i) { const int k = 8 * (i >> 1) + 2 * g + (i & 1); v[i] = __builtin_nontemporal_load((const f32x4*)(src + (size_t)(k0 + k) * ldn + n0 + 4 * l15)); }
#pragma unroll
    for (int j = 0; j < 8; ++j)
#pragma unroll
        for (int c = 0; c < 4; ++c) {
            const unsigned w = cvt_pk_bf16(v[2 * j][c], v[2 * j + 1][c]);
            const int n = 4 * l15 + c;
            *(LAS unsigned*)(scr + n * 128 + ((j ^ (l15 & 7)) << 4) + g * 4) = w;
        }
    LDS_WAIT();
#pragma unroll
    for (int i = 0; i < 8; ++i) {
        const int n = (lane >> 3) + 8 * i, ch = lane & 7;
        const u32x4 o = *(const LAS u32x4*)(scr + n * 128 + ((ch ^ ((n >> 2) & 7)) << 4));
        *(u32x4*)(dst + (size_t)(drow0 + n) * 1024 + k0 + 8 * ch) = o;
    }
    LDS_WAIT();
}
struct Item8 { const float* src; unsigned char* dst; int ldn; int perm; };
__device__ __forceinline__ Item8 item8_decode(Frame& F, int r) {
    Item8 it;
    if (r < 32 * 8 * 64) { const int e = r / 512, q = r % 512, kb = q / 64, nb = q % 64, n0 = nb * 32, bj = n0 >> 10, j = (n0 & 1023) >> 7, c = n0 & 127;
        it.src = F.w_gu + (size_t)e * 1024 * 2048 + (size_t)(kb * 128) * 2048 + n0; it.ldn = 2048;
        it.dst = F.ws + WS_WGU + ((size_t)e * 2048 + 256 * j + bj * 128 + c) * 1024 + kb * 128; it.perm = 0; }
    else { r -= 32 * 8 * 64; const int e = r / 256, q = r % 256, kb = q / 32, nb = q % 32;
        it.src = F.w_dn + (size_t)e * 1024 * 1024 + (size_t)(kb * 128) * 1024 + nb * 32; it.ldn = 1024;
        const int c0 = nb * 32, pn = c0 >> 8, cc = c0 & 255, wc = cc >> 6, fqh = (cc >> 5) & 1;
        it.dst = F.ws + WS_WDN + ((size_t)e * 1024 + pn * 256 + wc * 32 + fqh * 16) * 1024 + kb * 128; it.perm = 1; }
    return it;
}
__device__ __forceinline__ void item8_load(const Item8& it, f32x4 (&v)[16], int lane) {
    const int l7 = lane & 7, G = lane >> 3;
#pragma unroll
    for (int i = 0; i < 16; ++i) { const int k = 32 * (i >> 2) + 4 * G + (i & 3); v[i] = __builtin_nontemporal_load((const f32x4*)(it.src + (size_t)k * it.ldn + 4 * l7)); }
}
__device__ __forceinline__ void item8_finish(const Item8& it, const f32x4 (&v)[16], LAS unsigned char* scr, int lane) {
    const int l7 = lane & 7, G = lane >> 3;
#pragma unroll
    for (int a = 0; a < 4; ++a)
#pragma unroll
        for (int c = 0; c < 4; ++c) {
            const unsigned w = pk4_fp8(v[4 * a][c] * W8_SCALE, v[4 * a + 1][c] * W8_SCALE, v[4 * a + 2][c] * W8_SCALE, v[4 * a + 3][c] * W8_SCALE);
            *(LAS unsigned*)(scr + (4 * l7 + c) * 128 + (((8 * a + G) ^ (4 * l7)) << 2)) = w;
        }
    LDS_WAIT();
#pragma unroll
    for (int i = 0; i < 4; ++i) {
        const int n = (lane >> 3) + 8 * i, q = lane & 7;
        const u32x4 o = *(const LAS u32x4*)(scr + n * 128 + ((q ^ (n >> 2)) << 4));
        const int dr = it.perm ? (((n >> 4) & 1) * 8 + ((n >> 3) & 1) * 128 + (n & 7)) : n;
        __builtin_nontemporal_store(o, (u32x4*)(it.dst + (size_t)dr * 1024 + 16 * q));
    }
    LDS_WAIT();
}
constexpr int I8_TOTAL = 32 * 8 * 64 + 32 * 8 * 32;
struct Item6 { const float* src; unsigned char* dst; };
__device__ __forceinline__ Item6 item6_decode(Frame& F, int r) {
    Item6 it; const int e = r >> 8, q = r & 255, kb = q >> 5, n0 = (q & 31) * 64, bj = n0 >> 10, j = (n0 & 1023) >> 7, c = n0 & 127;
    it.src = F.w_gu + (size_t)e * 1024 * 2048 + (size_t)(kb * 128) * 2048 + n0;
    it.dst = F.ws + WS_WGU + ((size_t)e * 2048 + 256 * j + bj * 128 + c) * 1024 + kb * 128;
    return it;
}
__device__ __forceinline__ void item6_load(const Item6& it, int H, f32x16 (&v)[4], int lane) {
#pragma unroll
    for (int q = 0; q < 4; ++q)
#pragma unroll
        for (int j = 0; j < 16; ++j) { const int k = (q >> 1) * 64 + 32 * H + (q & 1) * 16 + j; v[q][j] = __builtin_nontemporal_load(it.src + (size_t)k * 2048 + lane); }
}
__device__ __forceinline__ void item6_finish(int H, const f32x16 (&v)[4], LAS unsigned char* scr, int lane) {
#pragma unroll
    for (int gg = 0; gg < 2; ++gg) {
        f32x16 a, b;
#pragma unroll
        for (int j = 0; j < 16; ++j) { a[j] = __builtin_amdgcn_fmed3f(v[gg][j] * W6_SCALE, -7.5f, 7.5f); b[j] = __builtin_amdgcn_fmed3f(v[2 + gg][j] * W6_SCALE, -7.5f, 7.5f); }
        const u32x6 q6 = __builtin_amdgcn_cvt_scalef32_2xpk16_fp6_f32(a, b, 1.0f);
        const int g = 2 * H + gg;
        *(LAS u32x4*)(scr + lane * 128 + ((g ^ (lane & 7)) << 4)) = (u32x4){q6[0], q6[1], q6[2], q6[3]};
        *(LAS u32x4*)(scr + lane * 128 + (((4 + g) ^ (lane & 7)) << 4)) = (u32x4){q6[4], q6[5], 0u, 0u};
    }
}
__device__ __forceinline__ void item6_flush(const Item6& it, LAS unsigned char* scr, int lane) {
    LDS_WAIT();
#pragma unroll
    for (int i = 0; i < 8; ++i) {
        const int n = (lane >> 3) + 8 * i, q = lane & 7;
        const u32x4 o = *(const LAS u32x4*)(scr + n * 128 + ((q ^ (n & 7)) << 4));
        __builtin_nontemporal_store(o, (u32x4*)(it.dst + (size_t)n * 1024 + 16 * q));
    }
    LDS_WAIT();
}
constexpr int I6_TOTAL = 32 * 8 * 32;
template <bool ONCE = false>
__device__ __forceinline__ void conv_loop(Frame& F) {
    int lane = F.lane; asm volatile("" : "+v"(lane));
    {
        f32x16 va[4], vb[4];
        LAS unsigned char* scr6 = F.lds + F.wave * 8192;
        for (;;) {
            int base = 0;
            if (lane == 0) base = (int)atomicAdd(F.ctl + CW_CONV6, 2u);
            base = __builtin_amdgcn_readfirstlane(base);
            if (base >= I6_TOTAL) break;
            const Item6 i0 = item6_decode(F, base), i1 = item6_decode(F, base + 1);
            item6_load(i0, 0, va, lane); item6_load(i0, 1, vb, lane);
            item6_finish(0, va, scr6, lane); item6_load(i1, 0, va, lane);
            item6_finish(1, vb, scr6, lane); item6_load(i1, 1, vb, lane); item6_flush(i0, scr6, lane);
            item6_finish(0, va, scr6, lane);
            item6_finish(1, vb, scr6, lane); item6_flush(i1, scr6, lane);
            if (ONCE) return;
        }
    }
    LAS unsigned char* scr = F.lds + F.wave * 8192;
    f32x4 va[16], vb[16];
    for (;;) {
        int base = 0;
        if (lane == 0) base = (int)atomicAdd(F.ctl + CW_CONV, 8u);
        base = __builtin_amdgcn_readfirstlane(base) + 32 * 8 * 64;
        if (base >= I8_TOTAL) break;
        Item8 i0 = item8_decode(F, base), i1 = item8_decode(F, base + 1);
        item8_load(i0, va, lane); item8_load(i1, vb, lane);
#pragma unroll
        for (int k = 2; k < 8; k += 2) {
            item8_finish(i0, va, scr, lane); i0 = item8_decode(F, base + k); item8_load(i0, va, lane);
            item8_finish(i1, vb, scr, lane); i1 = item8_decode(F, base + k + 1); item8_load(i1, vb, lane);
        }
        item8_finish(i0, va, scr, lane);
        item8_finish(i1, vb, scr, lane);
        if (ONCE) return;
    }
}
__device__ __forceinline__ void p0_prologue(Frame& F) {
    LAS unsigned char* scr = F.lds + F.wave * 8192;
    const int gw = F.vcu * NWAVES + F.wave, NGW = F.G * NWAVES;
    constexpr int I_IN = 16 * 56, I_OUT = 16 * 16, NITEMS = I_IN + I_OUT;
    bf16_t* wt_in = (bf16_t*)(F.ws + WS_WIN); bf16_t* wt_out = (bf16_t*)(F.ws + WS_WOUT);
    for (int it = gw; it < NITEMS; it += NGW) {
        int r = it;
        if (r < I_IN) { const int kb = r / 56, nb = r % 56, n0 = nb * 64, tile = n0 >> 8, kind = tile >> 1;
            int drow = n0;
            if (kind == 0 || kind == 1 || kind == 4 || kind == 5) { const int w = n0 & 255, hd = w >> 7, bj = (w >> 6) & 1; drow = tile * 256 + bj * 128 + hd * 64; }
            tr_item(F.w_in, DIN, kb * 64, n0, wt_in, drow, scr, F.lane); continue; }
        r -= I_IN;
        { const int kb = r / 16, nb = r % 16; tr_item(F.w_out, 1024, kb * 64, nb * 64, wt_out, nb * 64, scr, F.lane); }
    }
    {
        bf16_t* hb = (bf16_t*)(F.ws + WS_H);
        f32x4 gv[4];
#pragma unroll
        for (int j = 0; j < 4; ++j) gv[j] = *((const f32x4*)F.norm_mix_g + F.lane + 64 * j);
        for (int m0 = gw; m0 < T; m0 += 2 * NGW) {
            f32x4 v[2][4];
#pragma unroll
            for (int b = 0; b < 2; ++b) { const int m = min(m0 + b * NGW, T - 1); const f32x4* xr = (const f32x4*)(F.x + (size_t)m * DM) + F.lane;
#pragma unroll
                for (int j = 0; j < 4; ++j) v[b][j] = __builtin_nontemporal_load(xr + 64 * j); }
#pragma unroll
            for (int b = 0; b < 2; ++b) { const int m = m0 + b * NGW; if (m >= T) break;
                float ssum = 0.f;
#pragma unroll
                for (int j = 0; j < 4; ++j) ssum += (v[b][j][0] * v[b][j][0] + v[b][j][1] * v[b][j][1]) + (v[b][j][2] * v[b][j][2] + v[b][j][3] * v[b][j][3]);
                const float rstd = 1.0f / sqrtf(wave_sum(ssum) * (1.0f / DM) + NORM_EPS);
                u32x2* o = (u32x2*)(hb + (size_t)m * DM) + F.lane;
#pragma unroll
                for (int j = 0; j < 4; ++j) { const f32x4 y = v[b][j] * rstd * gv[j]; u32x2 w = {cvt_pk_bf16(y[0], y[1]), cvt_pk_bf16(y[2], y[3])}; o[64 * j] = w; } }
        }
    }
    {
        unsigned short* whi = (unsigned short*)(F.ws + WS_WR); unsigned short* wlo = whi + 32768;
        for (int q = F.vcu * NTHR + F.tid; q < 1024 * 32; q += F.G * NTHR) {
            const int k = q >> 5, e = q & 31; const float v = F.w_router[q];
            const unsigned hi = cvt_pk_bf16(v, 0.f) & 0xffffu; const float lo = v - __uint_as_float(hi << 16);
            const int off = e * 1024 + ((((k >> 3) ^ (e & 15))) << 3) + (k & 7);
            whi[off] = (unsigned short)hi; wlo[off] = (unsigned short)(cvt_pk_bf16(lo, 0.f) & 0xffffu);
        }
    }
    {
        unsigned* rt = (unsigned*)(F.ws + WS_ROPE);
        for (int idx = (F.vcu * NTHR + F.tid); idx < 8192 * 64; idx += F.G * NTHR) {
            const int pos = idx >> 6, i = idx & 63;
            const float inv = exp2f(-(float)i * (13.287712379549449f / 64.0f));
            const float ang = (float)pos * inv;
            const double xd = (double)ang; const double n = __builtin_rint(xd * 0.6366197723675814);
            double r = __builtin_fma(-n, 1.5707963267948966, xd); r = __builtin_fma(-n, 6.123233995736766e-17, r);
            const double r2 = r * r;
            const double sn = r + r * r2 * (-1.0 / 6 + r2 * (1.0 / 120 + r2 * (-1.0 / 5040 + r2 * (1.0 / 362880 + r2 * (-1.0 / 39916800)))));
            const double cs = 1.0 + r2 * (-0.5 + r2 * (1.0 / 24 + r2 * (-1.0 / 720 + r2 * (1.0 / 40320 + r2 * (-1.0 / 3628800 + r2 * (1.0 / 479001600))))));
            const int q = ((int)n) & 3;
            const double so = (q == 0) ? sn : (q == 1) ? cs : (q == 2) ? -sn : -cs;
            const double co = (q == 0) ? cs : (q == 1) ? -sn : (q == 2) ? -cs : sn;
            { union { _Float16 h[2]; unsigned u; } pk; pk.h[0] = (_Float16)(float)co; pk.h[1] = (_Float16)(float)so; rt[idx] = pk.u; }
        }
    }
}

__device__ __forceinline__ int rr_off(int r, int ch) { return r * 256 + ((ch ^ (r & 15)) << 4); }
__device__ __forceinline__ int tr_off(int r, int cb) { return r * 256 + (cb ^ ((r & 7) << 5)); }
template <int MODE>
__device__ __forceinline__ void stage_tile(LAS unsigned char* img, const bf16_t* g, size_t gstride, int nrows, int tid) {
    for (int q = tid; q < nrows * 16; q += NTHR) {
        const int r = q >> 4, ch = q & 15;
        const u32x4 v = *(const u32x4*)(g + (size_t)r * gstride + ch * 8);
        *(LAS u32x4*)(img + (MODE == 0 ? rr_off(r, ch) : tr_off(r, ch * 16))) = v;
    }
}
__device__ __forceinline__ bf16x8 rr_frag(const LAS unsigned char* img, int r0, int ks, int i, int g) {
    return *(const LAS bf16x8*)(img + (r0 + i) * 256 + (((4 * ks + g) ^ i) << 4));
}
__device__ __forceinline__ s16x4 tr_frag(const LAS unsigned char* img, int rb, int cb, int i, int g) {
    const int row = 16 * rb + 4 * g + (i >> 2), colb = 32 * cb + 8 * (i & 3);
    return __builtin_amdgcn_ds_read_tr16_b64_v4i16((LAS s16x4*)(img + row * 256 + (colb ^ (((4 * g + (i >> 2)) & 7) << 5))));
}
__device__ __forceinline__ bf16x8 cat4(s16x4 a, s16x4 b) { return (bf16x8){a[0], a[1], a[2], a[3], b[0], b[1], b[2], b[3]}; }
__device__ __forceinline__ bf16x8 pack_f8(f32x4 a, f32x4 b) { u32x4 w = {cvt_pk_bf16(a[0], a[1]), cvt_pk_bf16(a[2], a[3]), cvt_pk_bf16(b[0], b[1]), cvt_pk_bf16(b[2], b[3])}; return as_bf16x8(w); }
#define MFMA16(a, b, c) __builtin_amdgcn_mfma_f32_16x16x32_bf16(a, b, c, 0, 0, 0)

struct BlkRegs { u32x4 k[4], v[4]; };
struct AttnSeq { const bf16_t* Q; const bf16_t* K; const bf16_t* V; int br, bh, d, r, nb0; };
__device__ __forceinline__ AttnSeq attn_run(Frame& F, int run) {
    AttnSeq q; q.br = run >> 8; const int rem = run & 255; q.bh = rem >> 4; const int x = rem & 15, dsh = 2 * q.br, rps = 16 >> dsh;
    q.d = 1 << dsh; q.r = x / rps; q.nb0 = 4 * (x % rps);
    const bf16_t* P = (const bf16_t*)(F.ws + WS_C);
    q.Q = P + (size_t)4 * T * 512 + (size_t)q.bh * SEQ * 128; q.K = P + (size_t)5 * T * 512 + (size_t)q.bh * SEQ * 128; q.V = P + (size_t)6 * T * 512 + (size_t)q.bh * SEQ * 128;
    return q;
}
__device__ __forceinline__ void blk_issue(Frame& F, const AttnSeq& q, int blk, BlkRegs& R) {
#pragma unroll
    for (int j = 0; j < 4; ++j) {
        const int c = F.tid + NTHR * j, row = c >> 4, ch = c & 15;
        const size_t off = ((size_t)(blk * 128 + row) * q.d + q.r) * 128 + ch * 8;
        R.k[j] = *(const u32x4*)(q.K + off); R.v[j] = *(const u32x4*)(q.V + off);
    }
}
__device__ __forceinline__ void blk_write(Frame& F, int slot, const BlkRegs& R) {
    LAS unsigned char* Kl = F.lds + slot * 32768; LAS unsigned char* Vl = F.lds + 65536 + slot * 32768;
#pragma unroll
    for (int j = 0; j < 4; ++j) {
        const int c = F.tid + NTHR * j, row = c >> 4, ch = c & 15;
        *(LAS u32x4*)(Kl + rr_off(row, ch)) = R.k[j]; *(LAS u32x4*)(Vl + tr_off(row, ch * 16)) = R.v[j];
    }
}
__device__ __forceinline__ void q_issue(Frame& F, const AttnSeq& q, int nb, bf16x8 (&qf)[4]) {
    const int lq = nb * 128 + 16 * F.wave + (F.lane & 15), g = F.lane >> 4;
#pragma unroll
    for (int ks = 0; ks < 4; ++ks) qf[ks] = *(const bf16x8*)(q.Q + ((size_t)lq * q.d + q.r) * 128 + 32 * ks + 8 * g);
}
__device__ __forceinline__ void attn_compute(Frame& F, const AttnSeq& q, int nb, int sp, const bf16x8 (&qf)[4]) {
    const int lane = F.lane, w = F.wave, i = lane & 15, g = lane >> 4;
    const int lq = nb * 128 + 16 * w + i;
    const float NEG = -__builtin_inff();
    int kof[4], vof[8];
#pragma unroll
    for (int ks = 0; ks < 4; ++ks) kof[ks] = i * 256 + (((4 * ks + g) ^ i) << 4);
    { const int rl = 4 * g + (i >> 2);
#pragma unroll
      for (int eb = 0; eb < 8; ++eb) vof[eb] = 65536 + rl * 256 + ((32 * eb + 8 * (i & 3)) ^ ((rl & 7) << 5)); }
    f32x4 sc[9];
    bf16x8 kf[2][4];
#define ATT_KB(kbi_) ((((w + (kbi_)) < 8) ? sp : (sp ^ 1)) * 32768 + ((w + (kbi_)) & 7) * 4096)
#define ATT_LDK(buf, kbi_) do { const int bo_ = ATT_KB(kbi_); _Pragma("unroll") for (int ks = 0; ks < 4; ++ks) kf[buf][ks] = *(const LAS bf16x8*)(F.lds + bo_ + kof[ks]); } while (0)
    ATT_LDK(0, 0);
#pragma unroll
    for (int kbi = 0; kbi < 9; ++kbi) {
        if (kbi + 1 < 9) ATT_LDK((kbi + 1) & 1, kbi + 1);
        f32x4 c = {0.f, 0.f, 0.f, 0.f};
#pragma unroll
        for (int ks = 0; ks < 4; ++ks) c = MFMA16(kf[kbi & 1][ks], qf[ks], c);
        sc[kbi] = c;
    }
#undef ATT_LDK
#pragma unroll
    for (int rg = 0; rg < 4; ++rg) { sc[0][rg] = (i <= 4 * g + rg) ? sc[0][rg] : NEG; sc[8][rg] = (i >= 4 * g + rg) ? sc[8][rg] : NEG; }
    if (nb == 0) {
#pragma unroll
        for (int kbi = 0; kbi < 8; ++kbi) if (w + kbi < 8) sc[kbi] = (f32x4){NEG, NEG, NEG, NEG};
    }
    float mx = fmaxf(fmaxf(sc[0][0], sc[0][1]), fmaxf(sc[0][2], sc[0][3]));
#pragma unroll
    for (int kbi = 1; kbi < 9; ++kbi) mx = fmaxf(mx, fmaxf(fmaxf(sc[kbi][0], sc[kbi][1]), fmaxf(sc[kbi][2], sc[kbi][3])));
    mx = fmaxf(mx, __shfl_xor(mx, 16)); mx = fmaxf(mx, __shfl_xor(mx, 32));
    const float mxl = -mx * 1.4426950408889634f;
    float den = 0.f;
#pragma unroll
    for (int kbi = 0; kbi < 9; ++kbi)
#pragma unroll
        for (int rg = 0; rg < 4; ++rg) { const float p = __builtin_amdgcn_exp2f(__builtin_fmaf(sc[kbi][rg], 1.4426950408889634f, mxl)); sc[kbi][rg] = p; den += p; }
    den += __shfl_xor(den, 16); den += __shfl_xor(den, 32);
    f32x4 o[8];
#pragma unroll
    for (int eb = 0; eb < 8; ++eb) o[eb] = (f32x4){0.f, 0.f, 0.f, 0.f};
    s16x4 vf[2][4][2];
#define ATT_LDV(buf, hs_) do { const int t_ = (hs_) >> 1, e0_ = 4 * ((hs_) & 1); const int b0_ = ATT_KB(2 * t_), b1_ = (2 * t_ + 1 < 9 && w + 2 * t_ + 1 <= 15) ? ATT_KB(2 * t_ + 1) : b0_; \
        _Pragma("unroll") for (int e = 0; e < 4; ++e) { vf[buf][e][0] = __builtin_amdgcn_ds_read_tr16_b64_v4i16((LAS s16x4*)(F.lds + b0_ + vof[e0_ + e])); \
                                                        vf[buf][e][1] = __builtin_amdgcn_ds_read_tr16_b64_v4i16((LAS s16x4*)(F.lds + b1_ + vof[e0_ + e])); } } while (0)
    ATT_LDV(0, 0);
#pragma unroll
    for (int hs = 0; hs < 10; ++hs) {
        if (hs + 1 < 10) ATT_LDV((hs + 1) & 1, hs + 1);
        const int t = hs >> 1;
        const f32x4 z = {0.f, 0.f, 0.f, 0.f};
        const bf16x8 pf = pack_f8(sc[2 * t], (2 * t + 1 < 9) ? sc[(2 * t + 1 < 9) ? 2 * t + 1 : 8] : z);
#pragma unroll
        for (int e = 0; e < 4; ++e) o[4 * (hs & 1) + e] = MFMA16(cat4(vf[hs & 1][e][0], vf[hs & 1][e][1]), pf, o[4 * (hs & 1) + e]);
    }
#undef ATT_LDV
#undef ATT_KB
    const float rden = __builtin_amdgcn_rcpf(den);
    const int tok = (q.bh >> 2) * SEQ + lq * q.d + q.r, h = q.bh & 3;
    bf16_t* ob = (bf16_t*)(F.ws + WS_OBR) + ((size_t)q.br * T + tok) * 512 + h * 128 + 4 * g;
#pragma unroll
    for (int eb = 0; eb < 8; ++eb) { const f32x4 v = o[eb] * rden; u32x2 wv = {cvt_pk_bf16(v[0], v[1]), cvt_pk_bf16(v[2], v[3])}; *(u32x2*)(ob + 16 * eb) = wv; }
    if (g == 0) ((float*)(F.ws + WS_LSE))[((size_t)q.br * T + tok) * 4 + h] = mx + __logf(den);
}
__device__ __forceinline__ void attn_all(Frame& F) {
    BlkRegs RA, RB; bf16x8 qn[4], qf[4];
    int run = F.vcu;
    if (run >= 768) return;
    AttnSeq q = attn_run(F, run);
    blk_issue(F, q, q.nb0 > 0 ? q.nb0 - 1 : 0, RA); blk_issue(F, q, q.nb0, RB); q_issue(F, q, q.nb0, qn);
    bool wrA = true;
    for (int j = 0;; ) {
        __syncthreads();
        if (wrA) blk_write(F, 1, RA);
        blk_write(F, j & 1, RB);
#pragma unroll
        for (int ks = 0; ks < 4; ++ks) { qf[ks] = qn[ks]; asm volatile("" : "+v"(qf[ks])); }
        __syncthreads();
        const AttnSeq qc = q; const int nb = q.nb0 + j, sp = (j & 1) ^ 1;
        bool more = true;
        if (j < 3) { blk_issue(F, q, nb + 1, RB); q_issue(F, q, nb + 1, qn); wrA = false; ++j; }
        else { run += F.G; if (run < 768) { q = attn_run(F, run); blk_issue(F, q, q.nb0 > 0 ? q.nb0 - 1 : 0, RA); blk_issue(F, q, q.nb0, RB); q_issue(F, q, q.nb0, qn); wrA = true; j = 0; } else more = false; }
        attn_compute(F, qc, nb, sp, qf);
        if (!more) break;
    }
}

__device__ __forceinline__ float ret_log2g(int h) { return log2f(1.0f - exp2f(-5.0f - (float)h)); }
__device__ __forceinline__ void kv_unit(Frame& F, int u) {
    const int bh = u >> 6, n = u & 63, h = bh & 3;
    const bf16_t* P = (const bf16_t*)(F.ws + WS_C);
    const bf16_t* Kg = P + (size_t)1 * T * 512 + ((size_t)bh * SEQ + n * 128) * 128;
    const bf16_t* Vg = P + (size_t)2 * T * 512 + ((size_t)bh * SEQ + n * 128) * 128;
    LAS unsigned char* Kl = F.lds; LAS unsigned char* Vl = F.lds + 32768;
    const int lane = F.lane, w = F.wave, i = lane & 15, g = lane >> 4;
    const float l2g = ret_log2g(h);
    u32x4 kr[4], vr[4];
#pragma unroll
    for (int j = 0; j < 4; ++j) { const int q = F.tid + NTHR * j; kr[j] = *(const u32x4*)(Kg + (size_t)q * 8); vr[j] = *(const u32x4*)(Vg + (size_t)q * 8); }
    __syncthreads();
#pragma unroll
    for (int j = 0; j < 4; ++j) {
        const int q = F.tid + NTHR * j, r = q >> 4, ch = q & 15;
        const float z = exp2f((float)(127 - r) * l2g);
        u32x4 o;
#pragma unroll
        for (int c = 0; c < 4; ++c) o[c] = cvt_pk_bf16(bflo(vr[j][c]) * z, bfhi(vr[j][c]) * z);
        *(LAS u32x4*)(Vl + tr_off(r, ch * 16)) = o;
        *(LAS u32x4*)(Kl + tr_off(r, ch * 16)) = kr[j];
    }
    __syncthreads();
    const int eb0 = 2 * (w & 3), db0 = 4 * (w >> 2);
    f32x4 acc[2][4];
#pragma unroll
    for (int a = 0; a < 2; ++a)
#pragma unroll
        for (int b = 0; b < 4; ++b) acc[a][b] = (f32x4){0.f, 0.f, 0.f, 0.f};
#pragma unroll
    for (int t = 0; t < 4; ++t) {
        bf16x8 af[2], bf[4];
#pragma unroll
        for (int a = 0; a < 2; ++a) af[a] = cat4(tr_frag(Vl, 2 * t, eb0 + a, i, g), tr_frag(Vl, 2 * t + 1, eb0 + a, i, g));
#pragma unroll
        for (int b = 0; b < 4; ++b) bf[b] = cat4(tr_frag(Kl, 2 * t, db0 + b, i, g), tr_frag(Kl, 2 * t + 1, db0 + b, i, g));
#pragma unroll
        for (int a = 0; a < 2; ++a)
#pragma unroll
            for (int b = 0; b < 4; ++b) acc[a][b] = MFMA16(bf[b], af[a], acc[a][b]);
    }
    bf16_t* kv = (bf16_t*)(F.ws + WS_KV) + (size_t)u * 16384;
#pragma unroll
    for (int a = 0; a < 2; ++a)
#pragma unroll
        for (int b = 0; b < 4; ++b) { u32x2 wv = {cvt_pk_bf16(acc[a][b][0], acc[a][b][1]), cvt_pk_bf16(acc[a][b][2], acc[a][b][3])};
            *(u32x2*)(kv + (16 * (eb0 + a) + i) * 128 + 16 * (db0 + b) + 4 * g) = wv; }
}

__device__ __forceinline__ void p3_scan(Frame& F) {
    const unsigned* kv = (const unsigned*)(F.ws + WS_KV); unsigned* st = (unsigned*)(F.ws + WS_ST);
    for (int q = F.vcu * NTHR + F.tid; q < 16 * 8192; q += F.G * NTHR) {
        const int bh = q >> 13, ep = q & 8191, h = bh & 3;
        const float dec = exp2f(128.0f * ret_log2g(h));
        const unsigned* src = kv + (size_t)bh * 64 * 8192 + ep; unsigned* dstp = st + (size_t)bh * 64 * 8192 + ep;
        float s0 = 0.f, s1 = 0.f;
#pragma unroll 16
        for (int n = 0; n < 64; ++n) { dstp[(size_t)n * 8192] = cvt_pk_bf16(s0, s1); const unsigned k = __builtin_nontemporal_load(src + (size_t)n * 8192); s0 = s0 * dec + bflo(k); s1 = s1 * dec + bfhi(k); }
    }
}

struct RetRegs { u32x4 tq[4], tk[4], tv[4], ts[4]; };
__device__ __forceinline__ void retout_issue(Frame& F, int u, RetRegs& R) {
    const bf16_t* P = (const bf16_t*)(F.ws + WS_C);
    const int bh = u >> 6, n = u & 63;
    const size_t hoff = ((size_t)bh * SEQ + n * 128) * 128;
    const bf16_t* sg = (const bf16_t*)(F.ws + WS_ST) + (size_t)u * 16384;
#pragma unroll
    for (int j = 0; j < 4; ++j) { const size_t q8 = (size_t)(F.tid + NTHR * j) * 8;
        R.tq[j] = __builtin_nontemporal_load((const u32x4*)(P + hoff + q8)); R.tk[j] = __builtin_nontemporal_load((const u32x4*)(P + (size_t)1 * T * 512 + hoff + q8));
        R.tv[j] = __builtin_nontemporal_load((const u32x4*)(P + (size_t)2 * T * 512 + hoff + q8)); R.ts[j] = __builtin_nontemporal_load((const u32x4*)(sg + q8)); }
}
__device__ __forceinline__ void retout_write(Frame& F, const RetRegs& R) {
    LAS unsigned char* Ql = F.lds; LAS unsigned char* Kl = F.lds + 32768; LAS unsigned char* Vl = F.lds + 65536; LAS unsigned char* Sl = F.lds + 98304;
#pragma unroll
    for (int j = 0; j < 4; ++j) { const int q = F.tid + NTHR * j, r = q >> 4, ch = q & 15;
        *(LAS u32x4*)(Ql + rr_off(r, ch)) = R.tq[j]; *(LAS u32x4*)(Kl + rr_off(r, ch)) = R.tk[j]; *(LAS u32x4*)(Vl + tr_off(r, ch * 16)) = R.tv[j]; *(LAS u32x4*)(Sl + rr_off(r, ch)) = R.ts[j]; }
}
__device__ __forceinline__ void retout_compute(Frame& F, int u) {
    const int bh = u >> 6, n = u & 63, h = bh & 3, b = bh >> 2;
    const bf16_t* P = (const bf16_t*)(F.ws + WS_C);
    const size_t hoff = ((size_t)bh * SEQ + n * 128) * 128;
    const LAS unsigned char* Ql = F.lds; const LAS unsigned char* Kl = F.lds + 32768; const LAS unsigned char* Vl = F.lds + 65536; const LAS unsigned char* Sl = F.lds + 98304;
    const int lane = F.lane, w = F.wave, i = lane & 15, g = lane >> 4;
    const float l2g = ret_log2g(h);
    bf16x8 qf[4];
#pragma unroll
    for (int ks = 0; ks < 4; ++ks) qf[ks] = rr_frag(Ql, 16 * w, ks, i, g);
    const int qi = 16 * w + i;
    f32x4 oi[8];
    { const float xi = exp2f((float)(qi + 1) * l2g);
      bf16x8 qx[4];
#pragma unroll
      for (int ks = 0; ks < 4; ++ks) { const u32x4 qw = *reinterpret_cast<const u32x4*>(&qf[ks]); u32x4 o;
#pragma unroll
          for (int c = 0; c < 4; ++c) o[c] = cvt_pk_bf16(bflo(qw[c]) * xi, bfhi(qw[c]) * xi);
          qx[ks] = as_bf16x8(o); }
#pragma unroll
      for (int eb = 0; eb < 8; ++eb) {
          f32x4 c = {0.f, 0.f, 0.f, 0.f};
#pragma unroll
          for (int ks = 0; ks < 4; ++ks) c = MFMA16(rr_frag(Sl, 16 * eb, ks, i, g), qx[ks], c);
          oi[eb] = c;
      } }
    for (int t = 0; 2 * t <= w; ++t) {
        f32x4 s0 = {0.f, 0.f, 0.f, 0.f}, s1 = {0.f, 0.f, 0.f, 0.f};
        const int jb0 = 2 * t, jb1 = 2 * t + 1;
#pragma unroll
        for (int ks = 0; ks < 4; ++ks) s0 = MFMA16(rr_frag(Kl, 16 * jb0, ks, i, g), qf[ks], s0);
        if (jb1 <= w) {
#pragma unroll
            for (int ks = 0; ks < 4; ++ks) s1 = MFMA16(rr_frag(Kl, 16 * jb1, ks, i, g), qf[ks], s1);
        }
#pragma unroll
        for (int rg = 0; rg < 4; ++rg) {
            const int d0 = qi - (16 * jb0 + 4 * g + rg), d1 = qi - (16 * jb1 + 4 * g + rg);
            s0[rg] = d0 >= 0 ? s0[rg] * exp2f((float)d0 * l2g) : 0.f;
            s1[rg] = d1 >= 0 ? s1[rg] * exp2f((float)d1 * l2g) : 0.f;
        }
        const bf16x8 pf = pack_f8(s0, s1);
#pragma unroll
        for (int eb = 0; eb < 8; ++eb) oi[eb] = MFMA16(cat4(tr_frag(Vl, jb0, eb, i, g), tr_frag(Vl, jb1, eb, i, g)), pf, oi[eb]);
    }
    float s = 0.f;
#pragma unroll
    for (int eb = 0; eb < 8; ++eb) s += (oi[eb][0] + oi[eb][1]) + (oi[eb][2] + oi[eb][3]);
    s += __shfl_xor(s, 16); s += __shfl_xor(s, 32);
    const float mean = s * (1.0f / 128.0f);
    float q2 = 0.f;
#pragma unroll
    for (int eb = 0; eb < 8; ++eb) { oi[eb] = oi[eb] - mean; q2 += (oi[eb][0] * oi[eb][0] + oi[eb][1] * oi[eb][1]) + (oi[eb][2] * oi[eb][2] + oi[eb][3] * oi[eb][3]); }
    q2 += __shfl_xor(q2, 16); q2 += __shfl_xor(q2, 32);
    const float rstd = 1.0f / sqrtf(q2 * (1.0f / 128.0f) + NORM_EPS);
    const bf16_t* gp = P + (size_t)3 * T * 512 + hoff + (size_t)qi * 128 + 4 * g;
    bf16_t* cp = (bf16_t*)(F.ws + WS_H) + ((size_t)(b * SEQ + n * 128 + qi)) * 1024 + h * 128 + 4 * g;
#pragma unroll
    for (int eb = 0; eb < 8; ++eb) {
        const u32x2 gv = *(const u32x2*)(gp + 16 * eb);
        const f32x4 y = oi[eb] * rstd;
        u32x2 wv = {cvt_pk_bf16(y[0] * bflo(gv[0]), y[1] * bfhi(gv[0])), cvt_pk_bf16(y[2] * bflo(gv[1]), y[3] * bfhi(gv[1]))};
        *(u32x2*)(cp + 16 * eb) = wv;
    }
}
__device__ __forceinline__ void retout_all(Frame& F) {
    RetRegs R;
    int u = F.vcu;
    if (u < 1024) retout_issue(F, u, R);
    while (u < 1024) {
        __syncthreads();
        retout_write(F, R);
        __syncthreads();
        const int un = u + F.G;
        if (un < 1024) retout_issue(F, un, R);
        retout_compute(F, u);
        u = un;
    }
}
__device__ __forceinline__ void combine_tokens(Frame& F) {
    const int gw = F.vcu * NWAVES + F.wave, NGW = F.G * NWAVES, lane = F.lane, h = lane >> 4;
    const bf16_t* ob = (const bf16_t*)(F.ws + WS_OBR); const float* lse = (const float*)(F.ws + WS_LSE);
    bf16_t* cat = (bf16_t*)(F.ws + WS_H);
    constexpr int NB = 4;
    for (int t0 = gw; t0 < T; t0 += NGW * NB) {
        float l[NB][3]; u32x4 v[NB][3];
#pragma unroll
        for (int b = 0; b < NB; ++b) { const int tok = min(t0 + b * NGW, T - 1);
#pragma unroll
            for (int br = 0; br < 3; ++br) { l[b][br] = lse[((size_t)br * T + tok) * 4 + h]; v[b][br] = __builtin_nontemporal_load((const u32x4*)(ob + ((size_t)br * T + tok) * 512 + lane * 8)); } }
#pragma unroll
        for (int b = 0; b < NB; ++b) { const int tok = t0 + b * NGW; if (tok >= T) break;
            const float m = fmaxf(l[b][0], fmaxf(l[b][1], l[b][2]));
            float w0 = __expf(l[b][0] - m), w1 = __expf(l[b][1] - m), w2 = __expf(l[b][2] - m); const float rs = 1.0f / (w0 + w1 + w2); w0 *= rs; w1 *= rs; w2 *= rs;
            u32x4 o;
#pragma unroll
            for (int j = 0; j < 4; ++j) o[j] = cvt_pk_bf16(w0 * bflo(v[b][0][j]) + w1 * bflo(v[b][1][j]) + w2 * bflo(v[b][2][j]), w0 * bfhi(v[b][0][j]) + w1 * bfhi(v[b][1][j]) + w2 * bfhi(v[b][2][j]));
            *(u32x4*)(cat + (size_t)tok * 1024 + 512 + lane * 8) = o; }
    }
}

__device__ __forceinline__ void p6_router(Frame& F) {
    LAS unsigned char* Whi = F.lds; LAS unsigned char* Wlo = F.lds + 65536;
    LAS unsigned char* misc = F.lds + MISC_OFF;
    LAS float* g2 = (LAS float*)(misc + MO_G2); LAS int* hist = (LAS int*)(misc + MO_HIST); LAS int* base = (LAS int*)(misc + MO_BASE);
    const int lane = F.lane, w = F.wave, i = lane & 15, g = lane >> 4;
    __syncthreads();
    {
        const u32x4* src = (const u32x4*)(F.ws + WS_WR); u32x4 t[16];
#pragma unroll
        for (int j = 0; j < 16; ++j) t[j] = src[F.tid + NTHR * j];
#pragma unroll
        for (int j = 0; j < 16; ++j) *(LAS u32x4*)(F.lds + (size_t)(F.tid + NTHR * j) * 16) = t[j];
    }
    for (int q = F.tid; q < 1024; q += NTHR) g2[q] = F.norm_ffn_g[q];
    if (F.tid < 32) hist[F.tid] = 0;
    __syncthreads();
    const bf16_t* x1 = (const bf16_t*)(F.ws + WS_X1); unsigned char* h2u = F.ws + WS_H;
    for (int grp = F.vcu; grp * 128 < T; grp += F.G) {
        const int tok = grp * 128 + 16 * w + i;
        const bf16_t* xr = x1 + (size_t)tok * 1024 + 16 * g;
        f32x4 acc[2] = {{0.f, 0.f, 0.f, 0.f}, {0.f, 0.f, 0.f, 0.f}};
        float ss = 0.f;
#pragma unroll 1
        for (int kp = 0; kp < 8; ++kp) {
            f32x16 pa, pb;
#pragma unroll
            for (int hh = 0; hh < 2; ++hh) {
                const int kb = 2 * kp + hh;
                f32x4 y[4];
                const u32x4 xa = *(const u32x4*)(xr + 64 * kb), xb = *(const u32x4*)(xr + 64 * kb + 8);
#pragma unroll
                for (int c = 0; c < 4; ++c) {
                    const unsigned w0 = (c < 2 ? xa : xb)[2 * (c & 1)], w1 = (c < 2 ? xa : xb)[2 * (c & 1) + 1];
                    const f32x4 xv = {bflo(w0), bfhi(w0), bflo(w1), bfhi(w1)}, gv = *(const LAS f32x4*)(g2 + 64 * kb + 16 * g + 4 * c);
                    ss += (xv[0] * xv[0] + xv[1] * xv[1]) + (xv[2] * xv[2] + xv[3] * xv[3]);
                    y[c] = xv * gv;
#pragma unroll
                    for (int j = 0; j < 4; ++j) { const float q = __builtin_amdgcn_fmed3f(y[c][j] * H6_SCALE, -7.5f, 7.5f); if (hh) pb[4 * c + j] = q; else pa[4 * c + j] = q; }
                }
#pragma unroll
                for (int st = 0; st < 2; ++st) {
                    const f32x4 ya = y[2 * st], yb = y[2 * st + 1];
                    u32x4 hw = {cvt_pk_bf16(ya[0], ya[1]), cvt_pk_bf16(ya[2], ya[3]), cvt_pk_bf16(yb[0], yb[1]), cvt_pk_bf16(yb[2], yb[3])};
                    const f32x4 ra = {ya[0] - bflo(hw[0]), ya[1] - bfhi(hw[0]), ya[2] - bflo(hw[1]), ya[3] - bfhi(hw[1])};
                    const f32x4 rb = {yb[0] - bflo(hw[2]), yb[1] - bfhi(hw[2]), yb[2] - bflo(hw[3]), yb[3] - bfhi(hw[3])};
                    const bf16x8 yh = as_bf16x8(hw), yl = pack_f8(ra, rb);
#pragma unroll
                    for (int eb = 0; eb < 2; ++eb) {
                        const int off = (16 * eb + i) * 2048 + (((8 * kb + 2 * g + st) ^ i) << 4);
                        const bf16x8 wh = *(const LAS bf16x8*)(Whi + off), wl = *(const LAS bf16x8*)(Wlo + off);
                        acc[eb] = MFMA16(wh, yh, acc[eb]); acc[eb] = MFMA16(wh, yl, acc[eb]); acc[eb] = MFMA16(wl, yh, acc[eb]);
                    }
                }
            }
            const u32x6 q6 = __builtin_amdgcn_cvt_scalef32_2xpk16_fp6_f32(pa, pb, 1.0f);
            unsigned char* hp = h2u + (size_t)tok * 1024 + 128 * kp + 16 * g;
            *(u32x4*)hp = (u32x4){q6[0], q6[1], q6[2], q6[3]};
            *(u32x4*)(hp + 64) = (u32x4){q6[4], q6[5], 0u, 0u};
        }
        ss += __shfl_xor(ss, 16); ss += __shfl_xor(ss, 32);
        const float rstd = 1.0f / sqrtf(ss * (1.0f / 1024.0f) + NORM_EPS);
        float lg[32];
#pragma unroll
        for (int eb = 0; eb < 2; ++eb)
#pragma unroll
            for (int rg = 0; rg < 4; ++rg) {
                const float v = acc[eb][rg] * rstd;
#pragma unroll
                for (int gg = 0; gg < 4; ++gg) lg[16 * eb + 4 * gg + rg] = __shfl(v, 16 * gg + i);
            }
#pragma unroll
        for (int e = 0; e < 32; ++e) lg[e] += F.b_router[e];
        float tv[4]; int ti[4];
#pragma unroll
        for (int k = 0; k < 4; ++k) {
            float bv = -__builtin_inff(); int bi = 0;
#pragma unroll
            for (int e = 0; e < 32; ++e) { const bool gt = lg[e] > bv; bv = gt ? lg[e] : bv; bi = gt ? e : bi; }
            tv[k] = bv; ti[k] = bi;
#pragma unroll
            for (int e = 0; e < 32; ++e) lg[e] = (e == bi) ? -__builtin_inff() : lg[e];
        }
        float gsum = 0.f, gt4[4];
#pragma unroll
        for (int k = 0; k < 4; ++k) { gt4[k] = __expf(tv[k] - tv[0]); gsum += gt4[k]; }
        int my_e = ti[0]; float my_g = gt4[0];
#pragma unroll
        for (int k = 1; k < 4; ++k) { my_e = (g == k) ? ti[k] : my_e; my_g = (g == k) ? gt4[k] : my_g; }
        my_g /= gsum;
        const int lrank = atomicAdd((int*)(hist + my_e), 1);
        __syncthreads();
        if (F.tid < 32) { base[F.tid] = (int)atomicAdd(F.ctl + CW_CNT + 64 * F.tid, (unsigned)hist[F.tid]); }
        __syncthreads();
        const int rank = base[my_e] + lrank;
        ((int*)(F.ws + WS_RTOK))[(size_t)my_e * T + rank] = tok;
        ((float*)(F.ws + WS_RGATE))[(size_t)my_e * T + rank] = my_g;
        ((float*)(F.ws + WS_RRSTD))[(size_t)my_e * T + rank] = rstd;
        ((int*)(F.ws + WS_SLOT))[tok * 4 + g] = my_e * T + rank;
        __syncthreads();
        if (F.tid < 32) hist[F.tid] = 0;
        __syncthreads();
    }
}

__device__ __forceinline__ void p9_final(Frame& F) {
    LAS unsigned char* misc = F.lds + MISC_OFF; const LAS int* tp = (const LAS int*)(misc + MO_TP);
    const int gw = F.vcu * NWAVES + F.wave, NGW = F.G * NWAVES, lane = F.lane;
    const bf16_t* x1 = (const bf16_t*)(F.ws + WS_X1); const unsigned char* yb = F.ws + WS_D; const int* slot = (const int*)(F.ws + WS_SLOT);
    f32x4 gv[4];
#pragma unroll
    for (int j = 0; j < 4; ++j) gv[j] = *((const f32x4*)F.norm_final_g + lane + 64 * j);
    constexpr int NB = 4;
    for (int t0 = gw; t0 < T; t0 += NGW * NB) {
        int sl[NB][4];
#pragma unroll
        for (int b = 0; b < NB; ++b) { const int tok = min(t0 + b * NGW, T - 1);
#pragma unroll
            for (int k = 0; k < 4; ++k) sl[b][k] = slot[tok * 4 + k]; }
        f32x4 v[NB][4]; unsigned y[NB][4][4];
#pragma unroll
        for (int b = 0; b < NB; ++b) { const int tok = min(t0 + b * NGW, T - 1);
#pragma unroll
            for (int j = 0; j < 4; ++j) { const u32x2 xw = __builtin_nontemporal_load((const u32x2*)(x1 + (size_t)tok * 1024) + lane + 64 * j); v[b][j] = (f32x4){bflo(xw[0]), bfhi(xw[0]), bflo(xw[1]), bfhi(xw[1])}; }
#pragma unroll
            for (int k = 0; k < 4; ++k) { const int e = sl[b][k] >> 15, rank = sl[b][k] & 32767; const size_t row = (size_t)tp[e] * 256 + rank;
                const unsigned* yr = (const unsigned*)(yb + row * 1024) + lane;
#pragma unroll
                for (int j = 0; j < 4; ++j) y[b][k][j] = __builtin_nontemporal_load(yr + 64 * j); } }
#pragma unroll
        for (int b = 0; b < NB; ++b) { const int tok = t0 + b * NGW; if (tok >= T) break;
#pragma unroll
            for (int k = 0; k < 4; ++k)
#pragma unroll
                for (int j = 0; j < 4; ++j) { const f32x2 lo = __builtin_amdgcn_cvt_pk_f32_fp8((int)y[b][k][j], false), hi = __builtin_amdgcn_cvt_pk_f32_fp8((int)y[b][k][j], true);
                    v[b][j][0] += lo[0] * (1.0f / YB8_SCALE); v[b][j][1] += lo[1] * (1.0f / YB8_SCALE); v[b][j][2] += hi[0] * (1.0f / YB8_SCALE); v[b][j][3] += hi[1] * (1.0f / YB8_SCALE); }
            float ssum = 0.f;
#pragma unroll
            for (int j = 0; j < 4; ++j) ssum += (v[b][j][0] * v[b][j][0] + v[b][j][1] * v[b][j][1]) + (v[b][j][2] * v[b][j][2] + v[b][j][3] * v[b][j][3]);
            const float rstd = 1.0f / sqrtf(wave_sum(ssum) * (1.0f / 1024.0f) + NORM_EPS);
#pragma unroll
            for (int j = 0; j < 4; ++j) __builtin_nontemporal_store(v[b][j] * rstd * gv[j], (f32x4*)(F.out + (size_t)tok * 1024) + lane + 64 * j); }
    }
}

__global__ void __launch_bounds__(NTHR, 2) hybrid_fwd(Args args) {
    extern __shared__ __attribute__((aligned(16))) unsigned char lds_raw[];
    Frame F;
    F.lds = (LAS unsigned char*)lds_raw;
    F.tid = threadIdx.x; F.lane = F.tid & 63; F.wave = __builtin_amdgcn_readfirstlane(F.tid >> 6);
    F.G = gridDim.x; { const int bx = blockIdx.x; F.vcu = (F.G % 8 == 0) ? (bx % 8) * (F.G / 8) + bx / 8 : bx; }
    F.x = args.in[0]; F.norm_mix_g = args.in[1]; F.w_in = args.in[2]; F.w_out = args.in[3]; F.norm_ffn_g = args.in[4]; F.w_router = args.in[5]; F.b_router = args.in[6];
    F.w_gu = args.in[7]; F.b_gu = args.in[8]; F.w_dn = args.in[9]; F.b_dn = args.in[10]; F.norm_final_g = args.in[11];
    F.out = args.out; F.ws = args.ws; F.ctl = (unsigned*)(args.ws + WS_CTL);
    const int lo = args.ph_lo, hi = args.ph_hi;
    if (F.tid < 4) ((LAS unsigned*)(F.lds + MISC_OFF + MO_BAR))[F.tid] = 0u;
    __syncthreads();
    XcdBarrier bar; bar.bar = F.ctl + CW_BAR; bar.x = 0; bar.st = (volatile LAS unsigned*)(F.lds + MISC_OFF + MO_BAR);
    if (hi - lo > 1) bar = xcd_barrier_post(F.ctl + CW_BAR, (volatile LAS unsigned*)(F.lds + MISC_OFF + MO_BAR));
#define IN(k) (lo <= (k) && (k) < hi)
#define SEAM(k) do { if (IN(k) && IN((k) + 1)) xcd_barrier(bar); } while (0)

#define PHASE(k, ...) if (IN(k)) { { constexpr bool kRep = false; constexpr int kMode = 0; (void)kRep; (void)kMode; __VA_ARGS__ } if (REP_PH == (k)) { constexpr bool kRep = (REP_NOEPI != 0); constexpr int kMode = REP_NOEPI; (void)kRep; (void)kMode; __VA_ARGS__ } }
    PHASE(0, p0_prologue(F); )
    SEAM(0);
    PHASE(1, {
        const int bx = (int)blockIdx.x, qg = bx >> 3; const bool conv_only = (F.G == 256) && ((qg & 7) == 0);
        if (!conv_only) {
            const int Gg = (F.G == 256) ? 224 : F.G, cg = (F.G == 256) ? ((qg - (qg >> 3) - 1) * 8 + (bx & 7)) : bx;
            ProjProb S; S.so.init(T, DIN, Gg, cg); S.A = (const char*)(F.ws + WS_H); S.Bt = (const char*)(F.ws + WS_WIN); S.dst = (bf16_t*)(F.ws + WS_C);
            S.rt = (const unsigned*)(F.ws + WS_ROPE); S.misc = F.lds + MISC_OFF;
            {
                LAS unsigned* ta = (LAS unsigned*)(F.lds + MISC_OFF + MO_G2); LAS unsigned* tbb = (LAS unsigned*)(F.lds + MISC_OFF + MO_ROPEB);
                for (int q = F.tid; q < 1024; q += NTHR) { ta[q] = S.rt[q]; tbb[q] = S.rt[(q >> 6) * 1024 + (q & 63)]; }
                __syncthreads();
            }
            const int kbrk = 1 + (cg & 7);
            for (int part = 0; part < 2; ++part) {
                S.i0 = part ? kbrk : 0; S.i1 = part ? (1 << 30) : kbrk;
                pg8::gemm_phase<ProjProb, kRep>(F.lds, S);
                if (part == 0 && !kRep && kMode == 0) { conv_loop<true>(F); __syncthreads(); }
            }
        }
        if (!kRep && kMode == 0) conv_loop<false>(F); })
    SEAM(1);
    PHASE(2, {
        if (kMode != 2) attn_all(F);
        if (kMode != 1) for (int u = F.vcu; u < 1024; u += F.G) kv_unit(F, u);
        __syncthreads(); })
    SEAM(2);
    PHASE(3, p3_scan(F); )
    SEAM(3);
    PHASE(4, {
        if (kMode != 2) retout_all(F);
        if (kMode != 1) combine_tokens(F);
        __syncthreads(); })
    SEAM(4);
    PHASE(5, {
        OutProb S; S.so.init(T, DM, F.G, (int)blockIdx.x); S.A = (const char*)(F.ws + WS_H); S.Bt = (const char*)(F.ws + WS_WOUT); S.x = F.x; S.x1 = (bf16_t*)(F.ws + WS_X1);
        pg8::gemm_phase<OutProb, kRep>(F.lds, S); })
    SEAM(5);
    if (IN(6)) { p6_router(F); }
    SEAM(6);
    PHASE(7, {
        moe_tables(F);
        GuProb S; S.misc = F.lds + MISC_OFF; S.G = F.G; S.vcu = F.vcu; S.A = (const char*)(F.ws + WS_H); S.Bt = (const char*)(F.ws + WS_WGU);
        S.rtok = (const int*)(F.ws + WS_RTOK); S.rrstd = (const float*)(F.ws + WS_RRSTD); S.bias = F.b_gu; S.act = F.ws + WS_C;
        pg8::gemm_phase<GuProb, kRep>(F.lds, S); })
    SEAM(7);
    PHASE(8, {
        moe_tables(F);
        DnProb S; S.misc = F.lds + MISC_OFF; S.G = F.G; S.vcu = F.vcu; S.A = (const char*)(F.ws + WS_C); S.Bt = (const char*)(F.ws + WS_WDN);
        S.rgate = (const float*)(F.ws + WS_RGATE); S.bias = F.b_dn; S.yb = F.ws + WS_D;
        pg8::gemm_phase<DnProb, kRep>(F.lds, S); })
    SEAM(8);
    PHASE(9, { moe_tables(F); p9_final(F); })
#undef PHASE
#undef IN
#undef SEAM
}

extern "C" void kernel_launch(void* const* d_in, const int* in_sizes, int n_in, void* d_out, int out_size, void* d_ws, size_t ws_size, hipStream_t stream) {
    static int grid = 0;
    if (grid == 0) {
        if (n_in != 12 || out_size != T * DM || ws_size < WS_END) { fprintf(stderr, "kernel_launch: unexpected shapes (n_in %d out %d ws %zu)\n", n_in, out_size, ws_size); grid = -1; return; }
        int dev = 0, cus = 0, per_cu = 0;
        if (hipGetDevice(&dev) != hipSuccess || hipDeviceGetAttribute(&cus, hipDeviceAttributeMultiprocessorCount, dev) != hipSuccess) { grid = -1; return; }
        if (hipFuncSetAttribute((const void*)hybrid_fwd, hipFuncAttributeMaxDynamicSharedMemorySize, LDS_BYTES) != hipSuccess) { fprintf(stderr, "kernel_launch: hipFuncSetAttribute failed\n"); grid = -1; return; }
        if (hipOccupancyMaxActiveBlocksPerMultiprocessor(&per_cu, (const void*)hybrid_fwd, NTHR, LDS_BYTES) != hipSuccess || per_cu < 1) fprintf(stderr, "kernel_launch: occupancy query says %d\n", per_cu);
        (void)hipGetLastError();
        grid = cus;
    }
    if (grid < 0) return;
    (void)hipMemsetAsync((char*)d_ws + WS_CTL, 0, CTL_BYTES, stream);
    Args a{};
    for (int i = 0; i < 12; ++i) a.in[i] = (const float*)d_in[i];
    a.out = (float*)d_out; a.ws = (unsigned char*)d_ws;
    if (MK_N_LAUNCHES == 1) {
        a.ph_lo = 0; a.ph_hi = NPH;
        hipLaunchKernelGGL(hybrid_fwd, dim3(grid), dim3(NTHR), LDS_BYTES, stream, a);
    } else {
        for (int p = 0; p < NPH; ++p) { a.ph_lo = p; a.ph_hi = p + 1; hipLaunchKernelGGL(hybrid_fwd, dim3(grid), dim3(NTHR), LDS_BYTES, stream, a); }
    }
}
```

```cpp
#include <hip/hip_runtime.h>
#include <cstdio>
#include <cstdint>

#ifndef MK_N_LAUNCHES
#define MK_N_LAUNCHES 1
#endif

#ifndef REP_NOEPI
#define REP_NOEPI 0
#endif
#ifndef REP_PH
#define REP_PH (-1)
#endif

#define LAS __attribute__((address_space(3)))
#define GAS __attribute__((address_space(1)))
typedef unsigned short bf16_t;
typedef short bf16x8 __attribute__((ext_vector_type(8)));
typedef short s16x4 __attribute__((ext_vector_type(4)));
typedef float f32x4 __attribute__((ext_vector_type(4)));
typedef float f32x2 __attribute__((ext_vector_type(2)));
typedef unsigned u32x4 __attribute__((ext_vector_type(4)));
typedef unsigned u32x2 __attribute__((ext_vector_type(2)));
typedef int i32x8 __attribute__((ext_vector_type(8)));
typedef int i32x4 __attribute__((ext_vector_type(4)));
typedef int i32x6 __attribute__((ext_vector_type(6)));
typedef int i32x2 __attribute__((ext_vector_type(2)));
typedef unsigned u32x6 __attribute__((ext_vector_type(6)));
typedef float f32x16 __attribute__((ext_vector_type(16)));

constexpr int BATCH = 4, SEQ = 8192, DM = 1024, T = BATCH * SEQ, DIN = 3584, NEXP = 32;
constexpr int NWAVES = 8, NTHR = 512;
constexpr int MT_MAX = 544, PMAX = MT_MAX * 256;
constexpr float NORM_EPS = 1e-5f;
constexpr int NPH = 10;

constexpr size_t MiB = 1u << 20;
constexpr size_t WS_CTL = 0, CTL_BYTES = 1 * MiB;
constexpr size_t WS_ROPE = 1 * MiB;
constexpr size_t WS_WR = 3 * MiB;
constexpr size_t WS_WIN = 5 * MiB, WS_WOUT = 12 * MiB, WS_WGU = 14 * MiB, WS_WDN = 142 * MiB;
constexpr size_t WS_H = 206 * MiB;
constexpr size_t WS_X1 = 270 * MiB;
constexpr size_t WS_C = 398 * MiB;
constexpr size_t WS_D = 670 * MiB;
constexpr size_t WS_KV = WS_D, WS_ST = WS_D + 64 * MiB, WS_OBR = WS_D + 96 * MiB, WS_LSE = WS_D + 192 * MiB;
constexpr size_t WS_RT = 942 * MiB;
constexpr size_t WS_RTOK = WS_RT, WS_RGATE = WS_RT + 4 * MiB, WS_RRSTD = WS_RT + 8 * MiB, WS_SLOT = WS_RT + 12 * MiB;
constexpr size_t WS_END = 956 * MiB;
constexpr int CW_BAR = 4096;
constexpr int CW_CNT = 16384;
constexpr int CW_CONV6 = 24576;
constexpr int CW_CONV = 20480;

constexpr int RING_BYTES = 131072;
constexpr int MISC_OFF = RING_BYTES;
constexpr int LDS_BYTES = 147456;
constexpr int MO_BAR = 0;
constexpr int MO_CNT = 64;
constexpr int MO_TP = 256;
constexpr int MO_TE = 512;
constexpr int MO_HIST = 1280;
constexpr int MO_BASE = 1536;
constexpr int MO_G2 = 4096;
constexpr int MO_ROPEB = 12288;
constexpr int MO_EPI = 8192;

typedef __bf16 bf16x2_t __attribute__((ext_vector_type(2)));
__device__ __forceinline__ unsigned cvt_pk_bf16(float lo, float hi) { const bf16x2_t v = {(__bf16)lo, (__bf16)hi}; return __builtin_bit_cast(unsigned, v); }
__device__ __forceinline__ float bf2f(unsigned short b) { return __uint_as_float(((unsigned)b) << 16); }
__device__ __forceinline__ float bflo(unsigned w) { return __uint_as_float(w << 16); }
__device__ __forceinline__ float bfhi(unsigned w) { return __uint_as_float(w & 0xffff0000u); }
__device__ __forceinline__ float h2f_lo(unsigned w) { return (float)__builtin_bit_cast(_Float16, (unsigned short)(w & 0xffffu)); }
__device__ __forceinline__ float h2f_hi(unsigned w) { return (float)__builtin_bit_cast(_Float16, (unsigned short)(w >> 16)); }
__device__ __forceinline__ float clamp448(float v) { return __builtin_amdgcn_fmed3f(v, -448.0f, 448.0f); }
__device__ __forceinline__ unsigned pk4_fp8(float a, float b, float c, float d) {
    int w = __builtin_amdgcn_cvt_pk_fp8_f32(a, b, 0, false); w = __builtin_amdgcn_cvt_pk_fp8_f32(c, d, w, true); return (unsigned)w; }
constexpr float W6_SCALE = 64.0f, H6_SCALE = 1.5f;
constexpr float W8_SCALE = 64.0f, ACT8_SCALE = 4.0f, YB8_SCALE = 16.0f;
#define LDS_WAIT() asm volatile("s_waitcnt lgkmcnt(0)" ::: "memory")
#define VM_WAIT() asm volatile("s_waitcnt vmcnt(0)" ::: "memory")
__device__ __forceinline__ float wave_sum(float v) {
#pragma unroll
    for (int o = 1; o < 64; o <<= 1) v += __shfl_xor(v, o);
    return v;
}
__device__ __forceinline__ bf16x8 as_bf16x8(u32x4 w) { return *reinterpret_cast<bf16x8*>(&w); }

#define XB_TMO      128
#define XB_XCNT(j)  (256  + 64 * (j))
#define XB_XSUB(j)  (1280 + 64 * (j))
#define XB_XGEN(j)  (2304 + 64 * (j))
#define XB_TOP      3328
#define XB_TOPGEN   3392
#define XCD_BAR_WORDS 3456
#define XB_SPIN_CAP (1u << 18)
__device__ __forceinline__ unsigned xb_ld(unsigned* p)              { return __hip_atomic_load(p, __ATOMIC_RELAXED, __HIP_MEMORY_SCOPE_AGENT); }
__device__ __forceinline__ unsigned xb_add(unsigned* p, unsigned v) { return __hip_atomic_fetch_add(p, v, __ATOMIC_RELAXED, __HIP_MEMORY_SCOPE_AGENT); }
__device__ __forceinline__ unsigned xb_xcc_id() { return (unsigned)__builtin_amdgcn_s_getreg((3 << 11) | 20) & 0xFu; }
#define XB_SPIN(cond, bar) do { unsigned _sp = 0; while (cond) { __builtin_amdgcn_s_sleep(1); \
    if ((++_sp & 255u) == 0u) { if (xb_ld(&(bar)[XB_TMO])) break; if (_sp > XB_SPIN_CAP) { atomicAdd(&(bar)[XB_TMO], 1u); break; } } } } while (0)
struct XcdBarrier { unsigned* bar; unsigned x; volatile LAS unsigned* st; };
__device__ __forceinline__ XcdBarrier xcd_barrier_post(unsigned* bar, volatile LAS unsigned* st) {
    XcdBarrier b; b.bar = bar; b.x = xb_xcc_id(); b.st = st;
    if (threadIdx.x == 0) (void)xb_add(&bar[XB_XCNT(b.x)], 1u);
    return b;
}
__device__ __forceinline__ void xcd_barrier_complete(unsigned* bar, unsigned x, unsigned& nloc, unsigned& nx) {
    const unsigned G = gridDim.x * gridDim.y * gridDim.z;
    unsigned sum, cnt, mine, sp = 0u;
    for (;;) {
        sum = 0u; cnt = 0u; mine = 0u;
#pragma unroll
        for (unsigned j = 0; j < 16; ++j) { const unsigned c = xb_ld(&bar[XB_XCNT(j)]); sum += c; cnt += (c > 0u) ? 1u : 0u; mine = (j == x) ? c : mine; }
        if (sum == G) break;
        __builtin_amdgcn_s_sleep(1);
        if ((++sp & 255u) == 0u) { if (xb_ld(&bar[XB_TMO])) break; if (sp > XB_SPIN_CAP) { atomicAdd(&bar[XB_TMO], 1u); break; } }
    }
    nloc = mine > 0u ? mine : 1u; nx = cnt > 0u ? cnt : 1u;
}
__device__ __forceinline__ void xcd_barrier(const XcdBarrier& b) {
    asm volatile("s_waitcnt vmcnt(0)" ::: "memory");
    __syncthreads();
    if (threadIdx.x == 0) {
        unsigned* bar = b.bar;
        __builtin_amdgcn_s_waitcnt(0);
        unsigned nloc = b.st[0], nx = b.st[1];
        if (nloc == 0u) { xcd_barrier_complete(bar, b.x, nloc, nx); b.st[0] = nloc; b.st[1] = nx; }
        const unsigned old = xb_add(&bar[XB_XSUB(b.x)], 1u);
        const unsigned gen = old / nloc;
        if (old + 1u == (gen + 1u) * nloc) {
            __builtin_amdgcn_fence(__ATOMIC_RELEASE, "agent");
            asm volatile("s_waitcnt vmcnt(0)" ::: "memory");
            const unsigned og = xb_add(&bar[XB_TOP], 1u);
            const unsigned tg = og / nx;
            if (og + 1u == (tg + 1u) * nx) xb_add(&bar[XB_TOPGEN], 1u);
            else XB_SPIN(xb_ld(&bar[XB_TOPGEN]) == tg, bar);
            __builtin_amdgcn_fence(__ATOMIC_ACQUIRE, "agent");
            xb_add(&bar[XB_XGEN(b.x)], 1u);
            asm volatile("s_waitcnt vmcnt(0)" ::: "memory");
        } else {
            XB_SPIN(xb_ld(&bar[XB_XGEN(b.x)]) == gen, bar);
            __builtin_amdgcn_fence(__ATOMIC_ACQUIRE, "agent");
            asm volatile("s_waitcnt vmcnt(0)" ::: "memory");
        }
    }
    __syncthreads();
}

namespace pg8 {
constexpr int BM = 256, BK = 64, HALF = 128, HTB = HALF * BK * 2, NXCD = 8, WGM = 8, KD = 1024, NKT = KD / BK;
__device__ __forceinline__ int lds_byte(int r, int c) { const int st = (r >> 4) * 2 + (c >> 5), rr = r & 15, cc = c & 31, ob = rr * 64 + cc * 2; return st * 1024 + (ob ^ (((ob >> 9) & 1) << 5)); }
__device__ __forceinline__ void stage_rc(int b, int& R, int& C) { const int st = b / 1024, sb = b % 1024, swz = sb ^ (((sb >> 9) & 1) << 5); R = (st >> 1) * 16 + swz / 64; C = (st & 1) * 32 + (swz % 64) / 2; }
__device__ __forceinline__ int perm32(int rho) { const int n = rho >> 4, i = rho & 15; return 8 * (i >> 2) + 4 * n + (i & 3); }

struct StaticOrder {
    int nM, nN, nwg, G, c;
    __device__ void init(int M, int N, int G_, int c_) { nM = M / BM; nN = N / BM; nwg = nM * nN; G = G_; c = c_; }
    __device__ bool next(int i, int& pm, int& pn) const {
        const long L = (long)i * G + c; if (L >= nwg) return false;
        int wgid = (int)L; { const int q = nwg / NXCD, r = nwg % NXCD, xcd = wgid % NXCD, off = wgid / NXCD; wgid = (xcd < r ? xcd * (q + 1) : r * (q + 1) + (xcd - r) * q) + off; }
        const int nig = WGM * nN, gid = wgid / nig, fm = gid * WGM, gsz = (nM - fm) < WGM ? (nM - fm) : WGM;
        pm = fm + ((wgid % nig) % gsz); pn = (wgid % nig) / gsz; return true;
    }
};

template <bool SIX> struct FragOf { typedef i32x8 type; };
template <> struct FragOf<true> { typedef i32x6 type; };
template <int H> __device__ __forceinline__ bf16x8 half8(i32x8 v) { const i32x4 h = H ? __builtin_shufflevector(v, v, 4, 5, 6, 7) : __builtin_shufflevector(v, v, 0, 1, 2, 3); return *reinterpret_cast<const bf16x8*>(&h); }
template <class P, bool NOEPI = false>
__device__ __forceinline__ void gemm_phase(LAS unsigned char* lds, const P& S) {
    typedef typename P::U Unit;
    const int tid = threadIdx.x, wid = __builtin_amdgcn_readfirstlane(tid >> 6), lane = tid & 63, wr = wid >> 2, wc = wid & 3, fr = lane & 15, fq = lane >> 4;
    constexpr bool ZI = P::ZINIT;
    constexpr bool F8 = P::FP8, F6 = P::FP6;
    constexpr int PB = F8 ? 1024 : 2048, nt = F8 ? 8 : 16;
    int R0, C0, R1, C1; stage_rc(tid * 16, R0, C0); stage_rc(tid * 16 + 8192, R1, C1);
    unsigned voffB[2];
    { const int Rb0 = P::PERM ? ((R0 & ~31) + perm32(R0 & 31)) : R0, Rb1 = P::PERM ? ((R1 & ~31) + perm32(R1 & 31)) : R1;
      voffB[0] = (unsigned)(Rb0 * PB + C0 * 2); voffB[1] = (unsigned)(Rb1 * PB + C1 * 2); }
    constexpr size_t kstep = (size_t)(BK * 2);
    constexpr size_t hstep = (size_t)HALF * PB;
    const unsigned ldsw = (unsigned)wid * 1024u;
    const int aoff = lds_byte(wr * 64 + fr, fq * 8), boff = lds_byte(wc * 32 + fr, fq * 8);
#define PG8_SA(b, h) (((b) * 2 + (h)) * HTB)
#define PG8_SB(b, h) ((4 + (b) * 2 + (h)) * HTB)
#define PG8_STAGE(bufoff, gbase, voff) do { _Pragma("unroll") for (int _i = 0; _i < 2; ++_i) \
        __builtin_amdgcn_global_load_lds((const unsigned*)((const char*)(gbase) + (voff)[_i]), (LAS unsigned*)(lds + (bufoff) + ldsw + _i * 8192), 16, 0, 0); } while (0)
#define PG8_LDA(dst, b, h) do { _Pragma("unroll") for (int m = 0; m < 4; ++m) { const i32x4 _lo = *(const LAS i32x4*)(lds + PG8_SA(b, h) + aoff + m * 2048); \
        if constexpr (F6) { const i32x2 _h2 = *(const volatile LAS i32x2*)(lds + PG8_SA(b, h) + aoff + m * 2048 + 1024); const i32x4 _hi = __builtin_shufflevector(_h2, _h2, 0, 1, -1, -1); dst[m] = __builtin_shufflevector(_lo, _hi, 0, 1, 2, 3, 4, 5); } \
        else { const i32x4 _hi = *(const LAS i32x4*)(lds + PG8_SA(b, h) + aoff + m * 2048 + 1024); dst[m] = __builtin_shufflevector(_lo, _hi, 0, 1, 2, 3, 4, 5, 6, 7); } } } while (0)
#define PG8_LDB(dst, b, h) do { _Pragma("unroll") for (int n = 0; n < 2; ++n) { const i32x4 _lo = *(const LAS i32x4*)(lds + PG8_SB(b, h) + boff + n * 2048); \
        if constexpr (F6) { const i32x2 _h2 = *(const volatile LAS i32x2*)(lds + PG8_SB(b, h) + boff + n * 2048 + 1024); const i32x4 _hi = __builtin_shufflevector(_h2, _h2, 0, 1, -1, -1); dst[n] = __builtin_shufflevector(_lo, _hi, 0, 1, 2, 3, 4, 5); } \
        else { const i32x4 _hi = *(const LAS i32x4*)(lds + PG8_SB(b, h) + boff + n * 2048 + 1024); dst[n] = __builtin_shufflevector(_lo, _hi, 0, 1, 2, 3, 4, 5, 6, 7); } } } while (0)
#define PG8_MMA(ai, bj, At, Bt) do { __builtin_amdgcn_s_setprio(1); _Pragma("unroll") for (int m = 0; m < 4; ++m) _Pragma("unroll") for (int n = 0; n < 2; ++n) { \
        if constexpr (F6) { asm volatile("v_mfma_f32_16x16x128_f8f6f4 %0, %1, %2, %0 cbsz:2 blgp:2" : "+v"(acc[ai][bj][m][n]) : "v"(Bt[n]), "v"(At[m])); } \
        else if constexpr (F8) { asm volatile("v_mfma_f32_16x16x128_f8f6f4 %0, %1, %2, %0" : "+v"(acc[ai][bj][m][n]) : "v"(Bt[n]), "v"(At[m])); } \
        else { acc[ai][bj][m][n] = __builtin_amdgcn_mfma_f32_16x16x32_bf16(half8<0>(Bt[n]), half8<0>(At[m]), acc[ai][bj][m][n], 0, 0, 0); \
               acc[ai][bj][m][n] = __builtin_amdgcn_mfma_f32_16x16x32_bf16(half8<1>(Bt[n]), half8<1>(At[m]), acc[ai][bj][m][n], 0, 0, 0); } } \
        __builtin_amdgcn_s_setprio(0); } while (0)
#define PG8_MMA0(ai, bj, At, Bt) do { __builtin_amdgcn_s_setprio(1); _Pragma("unroll") for (int m = 0; m < 4; ++m) _Pragma("unroll") for (int n = 0; n < 2; ++n) { \
        if constexpr (F6) { asm volatile("v_mfma_f32_16x16x128_f8f6f4 %0, %1, %2, 0 cbsz:2 blgp:2" : "=&v"(acc[ai][bj][m][n]) : "v"(Bt[n]), "v"(At[m])); } \
        else if constexpr (F8) { asm volatile("v_mfma_f32_16x16x128_f8f6f4 %0, %1, %2, 0" : "=&v"(acc[ai][bj][m][n]) : "v"(Bt[n]), "v"(At[m])); } \
        else { acc[ai][bj][m][n] = __builtin_amdgcn_mfma_f32_16x16x32_bf16(half8<0>(Bt[n]), half8<0>(At[m]), (f32x4){0.f, 0.f, 0.f, 0.f}, 0, 0, 0); \
               acc[ai][bj][m][n] = __builtin_amdgcn_mfma_f32_16x16x32_bf16(half8<1>(Bt[n]), half8<1>(At[m]), acc[ai][bj][m][n], 0, 0, 0); } } \
        __builtin_amdgcn_s_setprio(0); } while (0)
#define PG8_MMAF(ai, bj, At, Bt) do { if (ZI && t == 0) PG8_MMA0(ai, bj, At, Bt); else PG8_MMA(ai, bj, At, Bt); } while (0)
#define PG8_INIT(u_) do { if constexpr (ZI) { _Pragma("unroll") for (int a_ = 0; a_ < 2; ++a_) _Pragma("unroll") for (int b_ = 0; b_ < 2; ++b_) _Pragma("unroll") for (int m_ = 0; m_ < 4; ++m_) _Pragma("unroll") for (int n_ = 0; n_ < 2; ++n_) \
        asm volatile("" : "=v"(acc[a_][b_][m_][n_])); } else S.init_acc(acc, u_, wr, wc, fr, fq); } while (0)
#define PG8_WAIT_V(n) asm volatile("s_waitcnt vmcnt(" #n ")" ::: "memory")
#define PG8_WAIT_L(n) asm volatile("s_waitcnt lgkmcnt(" #n ")" ::: "memory")
#define PG8_BAR __builtin_amdgcn_s_barrier()
#define PG8_SCHED __builtin_amdgcn_sched_barrier(0)
    Unit cur, nxt; int ui = 0;
    if (!S.next(0, cur)) return;
    f32x4 acc[2][2][4][2];
    PG8_INIT(cur);
    typename FragOf<F6>::type At[4], B0[2], B1[2];
    unsigned vc[2][2], vn[2][2];
    S.a_off(cur, R0, C0, R1, C1, vc);
    const char* const Ab = S.a_base();
    const char* cB = S.b_ptr(cur);
    S.pre_unit(cur, 0, wid, lane);
    PG8_STAGE(PG8_SB(0, 0), cB, voffB); PG8_STAGE(PG8_SA(0, 0), Ab, vc[0]); PG8_STAGE(PG8_SB(0, 1), cB + hstep, voffB); PG8_STAGE(PG8_SA(0, 1), Ab, vc[1]);
    if (wr == 1) PG8_BAR;
    PG8_WAIT_V(4); PG8_BAR;
    PG8_STAGE(PG8_SB(1, 0), cB + kstep, voffB); PG8_STAGE(PG8_SA(1, 0), Ab + kstep, vc[0]); PG8_STAGE(PG8_SB(1, 1), cB + hstep + kstep, voffB);
    PG8_WAIT_V(6); PG8_BAR;
    for (;;) {
        const bool has_next = S.next(ui + 1, nxt);
        const char* nB = cB;
        if (has_next) { S.a_off(nxt, R0, C0, R1, C1, vn); nB = S.b_ptr(nxt); }
        else {
#pragma unroll
            for (int h = 0; h < 2; ++h)
#pragma unroll
                for (int i = 0; i < 2; ++i) vn[h][i] = vc[h][i]; }
#pragma unroll 1
        for (int t = 0; t < nt; t += 2) {
            const bool last = (t == nt - 2);
            const char* a1 = Ab + (size_t)(t + 1) * kstep;
            const char* a2 = last ? Ab : Ab + (size_t)(t + 2) * kstep; const char* b2 = last ? nB : cB + (size_t)(t + 2) * kstep;
            const char* a3 = a2 + kstep; const char* b3 = b2 + kstep;
            unsigned vs[2][2];
#pragma unroll
            for (int h = 0; h < 2; ++h)
#pragma unroll
                for (int i = 0; i < 2; ++i) vs[h][i] = last ? vn[h][i] : vc[h][i];
            PG8_LDB(B0, 0, 0); PG8_SCHED; PG8_LDA(At, 0, 0); PG8_STAGE(PG8_SA(1, 1), a1, vc[1]);
            PG8_WAIT_L(8); PG8_BAR; PG8_WAIT_L(0); PG8_MMAF(0, 0, At, B0); PG8_BAR; PG8_SCHED;
            PG8_LDB(B1, 0, 1); PG8_STAGE(PG8_SB(0, 0), b2, voffB);
            PG8_BAR; PG8_WAIT_L(0); PG8_MMAF(0, 1, At, B1); PG8_BAR;
            PG8_LDA(At, 0, 1); PG8_STAGE(PG8_SA(0, 0), a2, vs[0]);
            PG8_BAR; PG8_WAIT_L(0); PG8_MMAF(1, 0, At, B0); PG8_BAR; PG8_SCHED;
            PG8_STAGE(PG8_SB(0, 1), b2 + hstep, voffB);
            PG8_WAIT_V(6); PG8_BAR; PG8_MMAF(1, 1, At, B1); PG8_BAR;
            PG8_LDB(B0, 1, 0); PG8_SCHED; PG8_LDA(At, 1, 0); PG8_STAGE(PG8_SA(0, 1), a2, vs[1]);
            PG8_WAIT_L(8); PG8_BAR; PG8_WAIT_L(0); PG8_MMA(0, 0, At, B0); PG8_BAR; PG8_SCHED;
            PG8_LDB(B1, 1, 1); PG8_STAGE(PG8_SB(1, 0), b3, voffB);
            PG8_BAR; PG8_WAIT_L(0); PG8_MMA(0, 1, At, B1); PG8_BAR;
            PG8_LDA(At, 1, 1); PG8_STAGE(PG8_SA(1, 0), a3, vs[0]);
            PG8_BAR; PG8_WAIT_L(0); PG8_MMA(1, 0, At, B0); PG8_BAR; PG8_SCHED;
            PG8_STAGE(PG8_SB(1, 1), b3 + hstep, voffB);
            PG8_WAIT_V(6); PG8_BAR; PG8_MMA(1, 1, At, B1); PG8_BAR;
        }
        if constexpr (F8) asm volatile("s_nop 15\n\ts_nop 15" ::: "memory");
        if constexpr (!NOEPI) S.epi(acc, cur, wr, wc, fr, fq, ui & 1);
        else {
#pragma unroll
            for (int a = 0; a < 2; ++a)
#pragma unroll
                for (int b = 0; b < 2; ++b)
#pragma unroll
                    for (int m = 0; m < 4; ++m)
#pragma unroll
                        for (int n = 0; n < 2; ++n) asm volatile("" :: "v"(acc[a][b][m][n]));
        }
        if (!has_next) break;
        PG8_INIT(nxt);
        cur = nxt; cB = nB; ++ui;
        S.pre_unit(cur, ui & 1, wid, lane);
#pragma unroll
        for (int h = 0; h < 2; ++h)
#pragma unroll
            for (int i = 0; i < 2; ++i) vc[h][i] = vn[h][i];
    }
    PG8_WAIT_V(0);
    if (wr == 0) PG8_BAR;
    PG8_BAR;
#undef PG8_SA
#undef PG8_SB
#undef PG8_STAGE
#undef PG8_LDA
#undef PG8_LDB
#undef PG8_MMA
#undef PG8_MMA0
#undef PG8_MMAF
#undef PG8_INIT
#undef PG8_WAIT_V
#undef PG8_WAIT_L
#undef PG8_BAR
#undef PG8_SCHED
}
}

struct Frame {
    LAS unsigned char* lds;
    int tid, lane, wave, G, vcu;
    const float *x, *norm_mix_g, *w_in, *w_out, *norm_ffn_g, *w_router, *b_router, *w_gu, *b_gu, *w_dn, *b_dn, *norm_final_g;
    float* out; unsigned char* ws; unsigned* ctl;
};
struct Args { const float* in[12]; float* out; unsigned char* ws; int ph_lo, ph_hi; };

__device__ __forceinline__ void zero_acc(f32x4 (&acc)[2][2][4][2]) {
#pragma unroll
    for (int a = 0; a < 2; ++a)
#pragma unroll
        for (int b = 0; b < 2; ++b)
#pragma unroll
            for (int m = 0; m < 4; ++m)
#pragma unroll
                for (int n = 0; n < 2; ++n) acc[a][b][m][n] = (f32x4){0.f, 0.f, 0.f, 0.f};
}
template <int PB = 2048>
__device__ __forceinline__ void dense_a_off(int row0, int R0, int C0, int R1, int C1, unsigned (&vo)[2][2]) {
#pragma unroll
    for (int h = 0; h < 2; ++h) { vo[h][0] = (unsigned)((row0 + 128 * h + R0) * PB + C0 * 2); vo[h][1] = (unsigned)((row0 + 128 * h + R1) * PB + C1 * 2); }
}

struct Cx8 { f32x4 c0, c1, s0, s1; };
__device__ __forceinline__ Cx8 cx8_lds(const LAS unsigned* p) {
    const u32x4 t0 = *(const LAS u32x4*)p, t1 = *(const LAS u32x4*)(p + 4); Cx8 r;
#pragma unroll
    for (int j = 0; j < 4; ++j) { r.c0[j] = h2f_lo(t0[j]); r.s0[j] = h2f_hi(t0[j]); r.c1[j] = h2f_lo(t1[j]); r.s1[j] = h2f_hi(t1[j]); }
    return r;
}
__device__ __forceinline__ Cx8 cx8_mul(const Cx8& a, const Cx8& b) {
    Cx8 r; r.c0 = a.c0 * b.c0 - a.s0 * b.s0; r.s0 = a.c0 * b.s0 + a.s0 * b.c0; r.c1 = a.c1 * b.c1 - a.s1 * b.s1; r.s1 = a.c1 * b.s1 + a.s1 * b.c1; return r;
}
struct ProjProb {
    struct U { int pm, pn; };
    static constexpr bool PERM = true, FP8 = false, FP6 = false, ZINIT = true;
    pg8::StaticOrder so; const char* A; const char* Bt; bf16_t* dst; const unsigned* rt; const LAS unsigned char* misc; int i0 = 0, i1 = 1 << 30;
    __device__ __forceinline__ bool next(int i, U& u) const { i += i0; if (i >= i1) return false; return so.next(i, u.pm, u.pn); }
    __device__ __forceinline__ void a_off(const U& u, int R0, int C0, int R1, int C1, unsigned (&vo)[2][2]) const { dense_a_off(u.pm * 256, R0, C0, R1, C1, vo); }
    __device__ __forceinline__ const char* a_base() const { return A; }
    __device__ __forceinline__ const char* b_ptr(const U& u) const { return Bt + (size_t)u.pn * (256 * 1024 * 2); }
    __device__ __forceinline__ void init_acc(f32x4 (&acc)[2][2][4][2], const U&, int, int, int, int) const { zero_acc(acc); }
    __device__ __forceinline__ void pre_unit(const U& u, int par, int wid, int lane) const {
        __builtin_amdgcn_global_load_lds(rt + (size_t)((u.pm * 256) & 8191) * 64 + lane, (LAS unsigned*)((LAS unsigned char*)misc + MO_EPI + par * 2048 + wid * 256), 4, 0, 0);
    }
    __device__ __forceinline__ void epi(const f32x4 (&acc)[2][2][4][2], const U& u, int wr, int wc, int fr, int fq, int par) const {
        const int kind = u.pn >> 1, hp = (u.pn & 1) * 2;
        bf16_t* base = dst + (size_t)kind * ((size_t)T * 512);
        const bool rot = (kind == 0) || (kind == 1) || (kind == 4) || (kind == 5);
        const float scale = (kind == 1 || kind == 4) ? 0.08838834764831845f : 1.0f;
        if (rot) {
            const int i0 = (wc & 1) * 32 + 8 * fq, h = hp + (wc >> 1);
            const LAS unsigned* TA = (const LAS unsigned*)(misc + MO_G2); const LAS unsigned* TB = (const LAS unsigned*)(misc + MO_ROPEB);
            const LAS unsigned* EP = (const LAS unsigned*)(misc + MO_EPI + par * 2048 + (wr * 4 + wc) * 256);
            Cx8 E0 = cx8_mul(cx8_mul(cx8_lds(EP + i0), cx8_lds(TB + (4 * wr) * 64 + i0)), cx8_lds(TA + fr * 64 + i0));
            E0.c0 *= scale; E0.c1 *= scale; E0.s0 *= scale; E0.s1 *= scale;
#pragma unroll
            for (int ai = 0; ai < 2; ++ai)
#pragma unroll
                for (int m = 0; m < 4; ++m) {
                    const int row = u.pm * 256 + ai * 128 + wr * 64 + m * 16 + fr, b = row >> 13, s = row & 8191;
                    const Cx8 E = cx8_mul(E0, cx8_lds(TB + (ai * 8 + m) * 64 + i0));
                    const f32x4 c0 = E.c0, c1 = E.c1, s0 = E.s0, s1 = E.s1;
                    const f32x4 a0 = acc[ai][0][m][0], a1 = acc[ai][0][m][1], b0 = acc[ai][1][m][0], b1 = acc[ai][1][m][1];
                    const f32x4 o10 = a0 * c0 - b0 * s0, o11 = a1 * c1 - b1 * s1;
                    const f32x4 o20 = a0 * s0 + b0 * c0, o21 = a1 * s1 + b1 * c1;
                    bf16_t* p = base + ((size_t)((b * 4 + h) * 8192 + s)) * 128 + i0;
                    u32x4 w1 = {cvt_pk_bf16(o10[0], o10[1]), cvt_pk_bf16(o10[2], o10[3]), cvt_pk_bf16(o11[0], o11[1]), cvt_pk_bf16(o11[2], o11[3])};
                    u32x4 w2 = {cvt_pk_bf16(o20[0], o20[1]), cvt_pk_bf16(o20[2], o20[3]), cvt_pk_bf16(o21[0], o21[1]), cvt_pk_bf16(o21[2], o21[3])};
                    *(u32x4*)p = w1; *(u32x4*)(p + 64) = w2;
                }
        } else {
            const int col = wc * 32 + 8 * fq;
#pragma unroll
            for (int ai = 0; ai < 2; ++ai)
#pragma unroll
                for (int m = 0; m < 4; ++m) {
                    const int row = u.pm * 256 + ai * 128 + wr * 64 + m * 16 + fr, b = row >> 13, s = row & 8191;
#pragma unroll
                    for (int bj = 0; bj < 2; ++bj) {
                        f32x4 v0 = acc[ai][bj][m][0], v1 = acc[ai][bj][m][1];
                        if (kind == 3) {
#pragma unroll
                            for (int j = 0; j < 4; ++j) { v0[j] = v0[j] * __builtin_amdgcn_rcpf(1.0f + __expf(-v0[j])); v1[j] = v1[j] * __builtin_amdgcn_rcpf(1.0f + __expf(-v1[j])); }
                        }
                        u32x4 w = {cvt_pk_bf16(v0[0], v0[1]), cvt_pk_bf16(v0[2], v0[3]), cvt_pk_bf16(v1[0], v1[1]), cvt_pk_bf16(v1[2], v1[3])};
                        *(u32x4*)(base + ((size_t)((b * 4 + hp + bj) * 8192 + s)) * 128 + col) = w;
                    }
                }
        }
    }
};

struct OutProb {
    struct U { int pm, pn; };
    static constexpr bool PERM = true, FP8 = false, FP6 = false, ZINIT = false;
    pg8::StaticOrder so; const char* A; const char* Bt; const float* x; bf16_t* x1;
    __device__ __forceinline__ bool next(int i, U& u) const { return so.next(i, u.pm, u.pn); }
    __device__ __forceinline__ void a_off(const U& u, int R0, int C0, int R1, int C1, unsigned (&vo)[2][2]) const { dense_a_off(u.pm * 256, R0, C0, R1, C1, vo); }
    __device__ __forceinline__ const char* a_base() const { return A; }
    __device__ __forceinline__ const char* b_ptr(const U& u) const { return Bt + (size_t)u.pn * (256 * 1024 * 2); }
    __device__ __forceinline__ void init_acc(f32x4 (&acc)[2][2][4][2], const U& u, int wr, int wc, int fr, int fq) const {
        const int row0 = u.pm * 256 + wr * 64 + fr, col0 = u.pn * 256 + wc * 32 + 8 * fq;
#pragma unroll
        for (int ai = 0; ai < 2; ++ai)
#pragma unroll
            for (int m = 0; m < 4; ++m) {
                const size_t off = (size_t)(row0 + ai * 128 + m * 16) * 1024 + col0;
#pragma unroll
                for (int bj = 0; bj < 2; ++bj)
#pragma unroll
                    for (int n = 0; n < 2; ++n) acc[ai][bj][m][n] = __builtin_nontemporal_load((const f32x4*)(x + off + bj * 128 + n * 4));
            }
    }
    __device__ __forceinline__ void pre_unit(const U&, int, int, int) const {}
    __device__ __forceinline__ void epi(const f32x4 (&acc)[2][2][4][2], const U& u, int wr, int wc, int fr, int fq, int) const {
        const int row0 = u.pm * 256 + wr * 64 + fr, col0 = u.pn * 256 + wc * 32 + 8 * fq;
#pragma unroll
        for (int ai = 0; ai < 2; ++ai)
#pragma unroll
            for (int m = 0; m < 4; ++m) {
                const size_t off = (size_t)(row0 + ai * 128 + m * 16) * 1024 + col0;
#pragma unroll
                for (int bj = 0; bj < 2; ++bj) { const f32x4 v0 = acc[ai][bj][m][0], v1 = acc[ai][bj][m][1];
                    u32x4 w = {cvt_pk_bf16(v0[0], v0[1]), cvt_pk_bf16(v0[2], v0[3]), cvt_pk_bf16(v1[0], v1[1]), cvt_pk_bf16(v1[2], v1[3])};
                    *(u32x4*)(x1 + off + bj * 128) = w; }
            }
    }
};

struct MoeU { int mt, pn, e, ml, cnt; };
template <int NNT>
__device__ __forceinline__ bool moe_next(const LAS unsigned char* misc, int i, int G, int vcu, MoeU& u) {
    const LAS int* tp = (const LAS int*)(misc + MO_TP);
    const int TM = tp[32], total = TM * NNT;
    const int L = i * G + vcu; if (L >= total) return false;
    const int full = TM / 8, grp = L / (8 * NNT);
    int mt, pn;
    if (grp < full) { mt = grp * 8 + (L % 8); pn = (L / 8) % NNT; }
    else { const int rem = L - full * 8 * NNT, gsz = TM - full * 8; mt = full * 8 + rem % gsz; pn = rem / gsz; }
    const int e = ((const LAS unsigned char*)(misc + MO_TE))[mt];
    u.mt = __builtin_amdgcn_readfirstlane(mt); u.pn = __builtin_amdgcn_readfirstlane(pn); u.e = __builtin_amdgcn_readfirstlane(e);
    u.ml = u.mt - __builtin_amdgcn_readfirstlane(tp[e]); u.cnt = __builtin_amdgcn_readfirstlane(((const LAS int*)(misc + MO_CNT))[e]);
    return true;
}
__device__ __forceinline__ void moe_tables(Frame& F) {
    LAS unsigned char* misc = F.lds + MISC_OFF;
    LAS int* cnt = (LAS int*)(misc + MO_CNT); LAS int* tp = (LAS int*)(misc + MO_TP); LAS unsigned char* te = (LAS unsigned char*)(misc + MO_TE);
    __syncthreads();
    if (F.tid < 32) cnt[F.tid] = (int)__hip_atomic_load(F.ctl + CW_CNT + 64 * F.tid, __ATOMIC_RELAXED, __HIP_MEMORY_SCOPE_AGENT);
    __syncthreads();
    if (F.tid == 0) { int s = 0; for (int e = 0; e < 32; ++e) { tp[e] = s; s += (cnt[e] + 255) >> 8; } tp[32] = s; }
    __syncthreads();
    if (F.tid < 32) { const int a = tp[F.tid], b = tp[F.tid + 1]; for (int t = a; t < b; ++t) te[t] = (unsigned char)F.tid; }
    __syncthreads();
}
struct GuProb {
    typedef MoeU U;
    static constexpr bool PERM = true, FP8 = true, FP6 = true, ZINIT = true;
    const LAS unsigned char* misc; int G, vcu;
    const char* A; const char* Bt; const int* rtok; const float* rrstd; const float* bias; unsigned char* act;
    __device__ __forceinline__ bool next(int i, U& u) const { return moe_next<8>(misc, i, G, vcu, u); }
    __device__ __forceinline__ void a_off(const U& u, int R0, int C0, int R1, int C1, unsigned (&vo)[2][2]) const {
        const int* rt = rtok + (size_t)u.e * T; const int rb = u.ml * 256, last = u.cnt - 1;
#pragma unroll
        for (int h = 0; h < 2; ++h) {
            const int r0 = min(rb + 128 * h + R0, last), r1 = min(rb + 128 * h + R1, last);
            const int t0 = rt[r0], t1 = rt[r1];
            vo[h][0] = (unsigned)(t0 * 1024 + C0 * 2); vo[h][1] = (unsigned)(t1 * 1024 + C1 * 2);
        }
    }
    __device__ __forceinline__ const char* a_base() const { return A; }
    __device__ __forceinline__ const char* b_ptr(const U& u) const { return Bt + ((size_t)u.e * 2048 + (size_t)u.pn * 256) * 1024; }
    __device__ __forceinline__ void init_acc(f32x4 (&acc)[2][2][4][2], const U&, int, int, int, int) const { zero_acc(acc); }
    __device__ __forceinline__ void pre_unit(const U& u, int par, int wid, int lane) const {
        const int idx = wid * 64 + lane;
        const float* src = (idx < 256) ? bias + (size_t)u.e * 2048 + (idx >> 7) * 1024 + u.pn * 128 + (idx & 127)
                                       : rrstd + (size_t)u.e * T + min(u.ml * 256 + (idx - 256), u.cnt - 1);
        __builtin_amdgcn_global_load_lds((const unsigned*)src, (LAS unsigned*)((LAS unsigned char*)misc + MO_EPI + par * 2048 + wid * 256), 4, 0, 0);
    }
    __device__ __forceinline__ void epi(const f32x4 (&acc)[2][2][4][2], const U& u, int wr, int wc, int fr, int fq, int par) const {
        const int cl = wc * 32 + 8 * fq;
        const LAS float* ev = (const LAS float*)(misc + MO_EPI + par * 2048);
        const f32x4 bg0 = *(const LAS f32x4*)(ev + cl), bg1 = *(const LAS f32x4*)(ev + cl + 4), bl0 = *(const LAS f32x4*)(ev + 128 + cl), bl1 = *(const LAS f32x4*)(ev + 128 + cl + 4);
        float rsv[2][4];
#pragma unroll
        for (int ai = 0; ai < 2; ++ai)
#pragma unroll
            for (int m = 0; m < 4; ++m) rsv[ai][m] = ev[256 + ai * 128 + wr * 64 + m * 16 + fr];
        asm volatile("" ::: "memory");
#pragma unroll
        for (int ai = 0; ai < 2; ++ai)
#pragma unroll
            for (int m = 0; m < 4; ++m) {
                const int r = ai * 128 + wr * 64 + m * 16 + fr;
                const float rstd = rsv[ai][m] * (1.0f / (W6_SCALE * H6_SCALE));
                const f32x2 rs2 = {rstd, rstd};
                int wq[2] = {0, 0};
#pragma unroll
                for (int hq = 0; hq < 4; ++hq) {
                    const int n = hq >> 1, p = 2 * (hq & 1);
                    const f32x4 av = acc[ai][0][m][n], bvv = acc[ai][1][m][n], bgv = n ? bg1 : bg0, blv = n ? bl1 : bl0;
                    const f32x2 a2 = {av[p], av[p + 1]}, b2 = {bvv[p], bvv[p + 1]}, bg2 = {bgv[p], bgv[p + 1]}, bl2 = {blv[p], blv[p + 1]};
                    f32x2 g2 = __builtin_elementwise_fma(a2, rs2, bg2), l2 = __builtin_elementwise_fma(b2, rs2, bl2);
                    g2[0] = fminf(g2[0], 7.0f); g2[1] = fminf(g2[1], 7.0f);
                    l2[0] = __builtin_amdgcn_fmed3f(l2[0], -7.0f, 7.0f); l2[1] = __builtin_amdgcn_fmed3f(l2[1], -7.0f, 7.0f);
                    const f32x2 t2 = g2 * (f32x2){-2.4554669595930157f, -2.4554669595930157f};
                    f32x2 e2 = {__builtin_amdgcn_exp2f(t2[0]), __builtin_amdgcn_exp2f(t2[1])};
                    e2 = e2 + (f32x2){1.0f, 1.0f};
                    const f32x2 r2 = {__builtin_amdgcn_rcpf(e2[0]), __builtin_amdgcn_rcpf(e2[1])};
                    const f32x2 u2 = __builtin_elementwise_fma(l2, (f32x2){ACT8_SCALE, ACT8_SCALE}, (f32x2){ACT8_SCALE, ACT8_SCALE});
                    const f32x2 o2 = (g2 * r2) * u2;
                    wq[hq >> 1] = (hq & 1) ? __builtin_amdgcn_cvt_pk_fp8_f32(o2[0], o2[1], wq[hq >> 1], true) : __builtin_amdgcn_cvt_pk_fp8_f32(o2[0], o2[1], wq[hq >> 1], false);
                }
                u32x2 w = {(unsigned)wq[0], (unsigned)wq[1]};
                *(u32x2*)(act + (size_t)(u.mt * 256 + r) * 1024 + u.pn * 128 + cl) = w;
            }
    }
};
struct DnProb {
    typedef MoeU U;
    static constexpr bool PERM = true, FP8 = true, FP6 = false, ZINIT = true;
    const LAS unsigned char* misc; int G, vcu;
    const char* A; const char* Bt; const float* rgate; const float* bias; unsigned char* yb;
    __device__ __forceinline__ bool next(int i, U& u) const { return moe_next<4>(misc, i, G, vcu, u); }
    __device__ __forceinline__ void a_off(const U& u, int R0, int C0, int R1, int C1, unsigned (&vo)[2][2]) const { dense_a_off<1024>(u.mt * 256, R0, C0, R1, C1, vo); }
    __device__ __forceinline__ const char* a_base() const { return A; }
    __device__ __forceinline__ const char* b_ptr(const U& u) const { return Bt + ((size_t)u.e * 1024 + (size_t)u.pn * 256) * 1024; }
    __device__ __forceinline__ void init_acc(f32x4 (&acc)[2][2][4][2], const U&, int, int, int, int) const { zero_acc(acc); }
    __device__ __forceinline__ void pre_unit(const U& u, int par, int wid, int lane) const {
        const int idx = wid * 64 + lane;
        const float* src = (idx < 256) ? bias + (size_t)u.e * 1024 + u.pn * 256 + idx : rgate + (size_t)u.e * T + min(u.ml * 256 + (idx - 256), u.cnt - 1);
        __builtin_amdgcn_global_load_lds((const unsigned*)src, (LAS unsigned*)((LAS unsigned char*)misc + MO_EPI + par * 2048 + wid * 256), 4, 0, 0);
    }
    __device__ __forceinline__ void epi(const f32x4 (&acc)[2][2][4][2], const U& u, int wr, int wc, int fr, int fq, int par) const {
        const int cb = wc * 64 + fq * 16;
        const LAS float* ev = (const LAS float*)(misc + MO_EPI + par * 2048);
        f32x4 bv[2][2];
#pragma unroll
        for (int bj = 0; bj < 2; ++bj) { bv[bj][0] = *(const LAS f32x4*)(ev + cb + bj * 8); bv[bj][1] = *(const LAS f32x4*)(ev + cb + bj * 8 + 4); }
        float gtv[2][4];
#pragma unroll
        for (int ai = 0; ai < 2; ++ai)
#pragma unroll
            for (int m = 0; m < 4; ++m) gtv[ai][m] = ev[256 + ai * 128 + wr * 64 + m * 16 + fr];
        asm volatile("" ::: "memory");
#pragma unroll
        for (int ai = 0; ai < 2; ++ai)
#pragma unroll
            for (int m = 0; m < 4; ++m) {
                const int r = ai * 128 + wr * 64 + m * 16 + fr;
                const float gate = gtv[ai][m] * YB8_SCALE;
                u32x4 w;
#pragma unroll
                for (int bj = 0; bj < 2; ++bj) {
                    const f32x4 v0 = (acc[ai][bj][m][0] * (1.0f / (W8_SCALE * ACT8_SCALE)) + bv[bj][0]) * gate, v1 = (acc[ai][bj][m][1] * (1.0f / (W8_SCALE * ACT8_SCALE)) + bv[bj][1]) * gate;
                    w[2 * bj] = pk4_fp8(clamp448(v0[0]), clamp448(v0[1]), clamp448(v0[2]), clamp448(v0[3])); w[2 * bj + 1] = pk4_fp8(clamp448(v1[0]), clamp448(v1[1]), clamp448(v1[2]), clamp448(v1[3]));
                }
                *(u32x4*)(yb + (size_t)(u.mt * 256 + r) * 1024 + u.pn * 256 + cb) = w;
            }
    }
};

__device__ __forceinline__ void tr_item(const float* __restrict__ src, int ldn, int k0, int n0, bf16_t* dst, int drow0, LAS unsigned char* scr, int lane) {
    const int l15 = lane & 15, g = lane >> 4;
    f32x4 v[16];
#pragma unroll
    for (int i = 0; i < 16; ++i) { const int k = 8 * (i >> 1) + 2 * g + (i & 1); v[i] = __builtin_nontemporal_load((const f32x4*)(src + (size_t)(k0 + k) * ldn + n0 + 4 * l15)); }
#pragma unroll
    for (int j = 0; j < 8; ++j)
#pragma unroll
        for (int c = 0; c < 4; ++c) {
            const unsigned w = cvt_pk_bf16(v[2 * j][c], v[2 * j + 1][c]);
            const int n = 4 * l15 + c;
            *(LAS unsigned*)(scr + n * 128 + ((j ^ (l15 & 7)) << 4) + g * 4) = w;
        }
    LDS_WAIT();
#pragma unroll
    for (int i = 0; i < 8; ++i) {
        const int n = (lane >> 3) + 8 * i, ch = lane & 7;
        const u32x4 o = *(const LAS u32x4*)(scr + n * 128 + ((ch ^ ((n >> 2) & 7)) << 4));
        *(u32x4*)(dst + (size_t)(drow0 + n) * 1024 + k0 + 8 * ch) = o;
    }
    LDS_WAIT();
}
struct Item8 { const float* src; unsigned char* dst; int ldn; int perm; };
__device__ __forceinline__ Item8 item8_decode(Frame& F, int r) {
    Item8 it;
    if (r < 32 * 8 * 64) { const int e = r / 512, q = r % 512, kb = q / 64, nb = q % 64, n0 = nb * 32, bj = n0 >> 10, j = (n0 & 1023) >> 7, c = n0 & 127;
        it.src = F.w_gu + (size_t)e * 1024 * 2048 + (size_t)(kb * 128) * 2048 + n0; it.ldn = 2048;
        it.dst = F.ws + WS_WGU + ((size_t)e * 2048 + 256 * j + bj * 128 + c) * 1024 + kb * 128; it.perm = 0; }
    else { r -= 32 * 8 * 64; const int e = r / 256, q = r % 256, kb = q / 32, nb = q % 32;
        it.src = F.w_dn + (size_t)e * 1024 * 1024 + (size_t)(kb * 128) * 1024 + nb * 32; it.ldn = 1024;
        const int c0 = nb * 32, pn = c0 >> 8, cc = c0 & 255, wc = cc >> 6, fqh = (cc >> 5) & 1;
        it.dst = F.ws + WS_WDN + ((size_t)e * 1024 + pn * 256 + wc * 32 + fqh * 16) * 1024 + kb * 128; it.perm = 1; }
    return it;
}
__device__ __forceinline__ void item8_load(const Item8& it, f32x4 (&v)[16], int lane) {
    const int l7 = lane & 7, G = lane >> 3;
#pragma unroll
    for (int i = 0; i < 16; ++i) { const int k = 32 * (i >> 2) + 4 * G + (i & 3); v[i] = __builtin_nontemporal_load((const f32x4*)(it.src + (size_t)k * it.ldn + 4 * l7)); }
}
__device__ __forceinline__ void item8_finish(const Item8& it, const f32x4 (&v)[16], LAS unsigned char* scr, int lane) {
    const int l7 = lane & 7, G = lane >> 3;
#pragma unroll
    for (int a = 0; a < 4; ++a)
#pragma unroll
        for (int c = 0; c < 4; ++c) {
            const unsigned w = pk4_fp8(v[4 * a][c] * W8_SCALE, v[4 * a + 1][c] * W8_SCALE, v[4 * a + 2][c] * W8_SCALE, v[4 * a + 3][c] * W8_SCALE);
            *(LAS unsigned*)(scr + (4 * l7 + c) * 128 + (((8 * a + G) ^ (4 * l7)) << 2)) = w;
        }
    LDS_WAIT();
#pragma unroll
    for (int i = 0; i < 4; ++i) {
        const int n = (lane >> 3) + 8 * i, q = lane & 7;
        const u32x4 o = *(const LAS u32x4*)(scr + n * 128 + ((q ^ (n >> 2)) << 4));
        const int dr = it.perm ? (((n >> 4) & 1) * 8 + ((n >> 3) & 1) * 128 + (n & 7)) : n;
        __builtin_nontemporal_store(o, (u32x4*)(it.dst + (size_t)dr * 1024 + 16 * q));
    }
    LDS_WAIT();
}
constexpr int I8_TOTAL = 32 * 8 * 64 + 32 * 8 * 32;
struct Item6 { const float* src; unsigned char* dst; };
__device__ __forceinline__ Item6 item6_decode(Frame& F, int r) {
    Item6 it; const int e = r >> 8, q = r & 255, kb = q >> 5, n0 = (q & 31) * 64, bj = n0 >> 10, j = (n0 & 1023) >> 7, c = n0 & 127;
    it.src = F.w_gu + (size_t)e * 1024 * 2048 + (size_t)(kb * 128) * 2048 + n0;
    it.dst = F.ws + WS_WGU + ((size_t)e * 2048 + 256 * j + bj * 128 + c) * 1024 + kb * 128;
    return it;
}
__device__ __forceinline__ void item6_load(const Item6& it, int H, f32x16 (&v)[4], int lane) {
#pragma unroll
    for (int q = 0; q < 4; ++q)
#pragma unroll
        for (int j = 0; j < 16; ++j) { const int k = (q >> 1) * 64 + 32 * H + (q & 1) * 16 + j; v[q][j] = __builtin_nontemporal_load(it.src + (size_t)k * 2048 + lane); }
}
__device__ __forceinline__ void item6_finish(int H, const f32x16 (&v)[4], LAS unsigned char* scr, int lane) {
#pragma unroll
    for (int gg = 0; gg < 2; ++gg) {
        f32x16 a, b;
#pragma unroll
        for (int j = 0; j < 16; ++j) { a[j] = __builtin_amdgcn_fmed3f(v[gg][j] * W6_SCALE, -7.5f, 7.5f); b[j] = __builtin_amdgcn_fmed3f(v[2 + gg][j] * W6_SCALE, -7.5f, 7.5f); }
        const u32x6 q6 = __builtin_amdgcn_cvt_scalef32_2xpk16_fp6_f32(a, b, 1.0f);
        const int g = 2 * H + gg;
        *(LAS u32x4*)(scr + lane * 128 + ((g ^ (lane & 7)) << 4)) = (u32x4){q6[0], q6[1], q6[2], q6[3]};
        *(LAS u32x4*)(scr + lane * 128 + (((4 + g) ^ (lane & 7)) << 4)) = (u32x4){q6[4], q6[5], 0u, 0u};
    }
}
__device__ __forceinline__ void item6_flush(const Item6& it, LAS unsigned char* scr, int lane) {
    LDS_WAIT();
#pragma unroll
    for (int i = 0; i < 8; ++i) {
        const int n = (lane >> 3) + 8 * i, q = lane & 7;
        const u32x4 o = *(const LAS u32x4*)(scr + n * 128 + ((q ^ (n & 7)) << 4));
        __builtin_nontemporal_store(o, (u32x4*)(it.dst + (size_t)n * 1024 + 16 * q));
    }
    LDS_WAIT();
}
constexpr int I6_TOTAL = 32 * 8 * 32;
template <bool ONCE = false>
__device__ __forceinline__ void conv_loop(Frame& F) {
    int lane = F.lane; asm volatile("" : "+v"(lane));
    {
        f32x16 va[4], vb[4];
        LAS unsigned char* scr6 = F.lds + F.wave * 8192;
        for (;;) {
            int base = 0;
            if (lane == 0) base = (int)atomicAdd(F.ctl + CW_CONV6, 2u);
            base = __builtin_amdgcn_readfirstlane(base);
            if (base >= I6_TOTAL) break;
            const Item6 i0 = item6_decode(F, base), i1 = item6_decode(F, base + 1);
            item6_load(i0, 0, va, lane); item6_load(i0, 1, vb, lane);
            item6_finish(0, va, scr6, lane); item6_load(i1, 0, va, lane);
            item6_finish(1, vb, scr6, lane); item6_load(i1, 1, vb, lane); item6_flush(i0, scr6, lane);
            item6_finish(0, va, scr6, lane);
            item6_finish(1, vb, scr6, lane); item6_flush(i1, scr6, lane);
            if (ONCE) return;
        }
    }
    LAS unsigned char* scr = F.lds + F.wave * 8192;
    f32x4 va[16], vb[16];
    for (;;) {
        int base = 0;
        if (lane == 0) base = (int)atomicAdd(F.ctl + CW_CONV, 8u);
        base = __builtin_amdgcn_readfirstlane(base) + 32 * 8 * 64;
        if (base >= I8_TOTAL) break;
        Item8 i0 = item8_decode(F, base), i1 = item8_decode(F, base + 1);
        item8_load(i0, va, lane); item8_load(i1, vb, lane);
#pragma unroll
        for (int k = 2; k < 8; k += 2) {
            item8_finish(i0, va, scr, lane); i0 = item8_decode(F, base + k); item8_load(i0, va, lane);
            item8_finish(i1, vb, scr, lane); i1 = item8_decode(F, base + k + 1); item8_load(i1, vb, lane);
        }
        item8_finish(i0, va, scr, lane);
        item8_finish(i1, vb, scr, lane);
        if (ONCE) return;
    }
}
__device__ __forceinline__ void p0_prologue(Frame& F) {
    LAS unsigned char* scr = F.lds + F.wave * 8192;
    const int gw = F.vcu * NWAVES + F.wave, NGW = F.G * NWAVES;
    constexpr int I_IN = 16 * 56, I_OUT = 16 * 16, NITEMS = I_IN + I_OUT;
    bf16_t* wt_in = (bf16_t*)(F.ws + WS_WIN); bf16_t* wt_out = (bf16_t*)(F.ws + WS_WOUT);
    for (int it = gw; it < NITEMS; it += NGW) {
        int r = it;
        if (r < I_IN) { const int kb = r / 56, nb = r % 56, n0 = nb * 64, tile = n0 >> 8, kind = tile >> 1;
            int drow = n0;
            if (kind == 0 || kind == 1 || kind == 4 || kind == 5) { const int w = n0 & 255, hd = w >> 7, bj = (w >> 6) & 1; drow = tile * 256 + bj * 128 + hd * 64; }
            tr_item(F.w_in, DIN, kb * 64, n0, wt_in, drow, scr, F.lane); continue; }
        r -= I_IN;
        { const int kb = r / 16, nb = r % 16; tr_item(F.w_out, 1024, kb * 64, nb * 64, wt_out, nb * 64, scr, F.lane); }
    }
    {
        bf16_t* hb = (bf16_t*)(F.ws + WS_H);
        f32x4 gv[4];
#pragma unroll
        for (int j = 0; j < 4; ++j) gv[j] = *((const f32x4*)F.norm_mix_g + F.lane + 64 * j);
        for (int m0 = gw; m0 < T; m0 += 2 * NGW) {
            f32x4 v[2][4];
#pragma unroll
            for (int b = 0; b < 2; ++b) { const int m = min(m0 + b * NGW, T - 1); const f32x4* xr = (const f32x4*)(F.x + (size_t)m * DM) + F.lane;
#pragma unroll
                for (int j = 0; j < 4; ++j) v[b][j] = __builtin_nontemporal_load(xr + 64 * j); }
#pragma unroll
            for (int b = 0; b < 2; ++b) { const int m = m0 + b * NGW; if (m >= T) break;
                float ssum = 0.f;
#pragma unroll
                for (int j = 0; j < 4; ++j) ssum += (v[b][j][0] * v[b][j][0] + v[b][j][1] * v[b][j][1]) + (v[b][j][2] * v[b][j][2] + v[b][j][3] * v[b][j][3]);
                const float rstd = 1.0f / sqrtf(wave_sum(ssum) * (1.0f / DM) + NORM_EPS);
                u32x2* o = (u32x2*)(hb + (size_t)m * DM) + F.lane;
#pragma unroll
                for (int j = 0; j < 4; ++j) { const f32x4 y = v[b][j] * rstd * gv[j]; u32x2 w = {cvt_pk_bf16(y[0], y[1]), cvt_pk_bf16(y[2], y[3])}; o[64 * j] = w; } }
        }
    }
    {
        unsigned short* whi = (unsigned short*)(F.ws + WS_WR); unsigned short* wlo = whi + 32768;
        for (int q = F.vcu * NTHR + F.tid; q < 1024 * 32; q += F.G * NTHR) {
            const int k = q >> 5, e = q & 31; const float v = F.w_router[q];
            const unsigned hi = cvt_pk_bf16(v, 0.f) & 0xffffu; const float lo = v - __uint_as_float(hi << 16);
            const int off = e * 1024 + ((((k >> 3) ^ (e & 15))) << 3) + (k & 7);
            whi[off] = (unsigned short)hi; wlo[off] = (unsigned short)(cvt_pk_bf16(lo, 0.f) & 0xffffu);
        }
    }
    {
        unsigned* rt = (unsigned*)(F.ws + WS_ROPE);
        for (int idx = (F.vcu * NTHR + F.tid); idx < 8192 * 64; idx += F.G * NTHR) {
            const int pos = idx >> 6, i = idx & 63;
            const float inv = exp2f(-(float)i * (13.287712379549449f / 64.0f));
            const float ang = (float)pos * inv;
            const double xd = (double)ang; const double n = __builtin_rint(xd * 0.6366197723675814);
            double r = __builtin_fma(-n, 1.5707963267948966, xd); r = __builtin_fma(-n, 6.123233995736766e-17, r);
            const double r2 = r * r;
            const double sn = r + r * r2 * (-1.0 / 6 + r2 * (1.0 / 120 + r2 * (-1.0 / 5040 + r2 * (1.0 / 362880 + r2 * (-1.0 / 39916800)))));
            const double cs = 1.0 + r2 * (-0.5 + r2 * (1.0 / 24 + r2 * (-1.0 / 720 + r2 * (1.0 / 40320 + r2 * (-1.0 / 3628800 + r2 * (1.0 / 479001600))))));
            const int q = ((int)n) & 3;
            const double so = (q == 0) ? sn : (q == 1) ? cs : (q == 2) ? -sn : -cs;
            const double co = (q == 0) ? cs : (q == 1) ? -sn : (q == 2) ? -cs : sn;
            { union { _Float16 h[2]; unsigned u; } pk; pk.h[0] = (_Float16)(float)co; pk.h[1] = (_Float16)(float)so; rt[idx] = pk.u; }
        }
    }
}

__device__ __forceinline__ int rr_off(int r, int ch) { return r * 256 + ((ch ^ (r & 15)) << 4); }
__device__ __forceinline__ int tr_off(int r, int cb) { return r * 256 + (cb ^ ((r & 7) << 5)); }
template <int MODE>
__device__ __forceinline__ void stage_tile(LAS unsigned char* img, const bf16_t* g, size_t gstride, int nrows, int tid) {
    for (int q = tid; q < nrows * 16; q += NTHR) {
        const int r = q >> 4, ch = q & 15;
        const u32x4 v = *(const u32x4*)(g + (size_t)r * gstride + ch * 8);
        *(LAS u32x4*)(img + (MODE == 0 ? rr_off(r, ch) : tr_off(r, ch * 16))) = v;
    }
}
__device__ __forceinline__ bf16x8 rr_frag(const LAS unsigned char* img, int r0, int ks, int i, int g) {
    return *(const LAS bf16x8*)(img + (r0 + i) * 256 + (((4 * ks + g) ^ i) << 4));
}
__device__ __forceinline__ s16x4 tr_frag(const LAS unsigned char* img, int rb, int cb, int i, int g) {
    const int row = 16 * rb + 4 * g + (i >> 2), colb = 32 * cb + 8 * (i & 3);
    return __builtin_amdgcn_ds_read_tr16_b64_v4i16((LAS s16x4*)(img + row * 256 + (colb ^ (((4 * g + (i >> 2)) & 7) << 5))));
}
__device__ __forceinline__ bf16x8 cat4(s16x4 a, s16x4 b) { return (bf16x8){a[0], a[1], a[2], a[3], b[0], b[1], b[2], b[3]}; }
__device__ __forceinline__ bf16x8 pack_f8(f32x4 a, f32x4 b) { u32x4 w = {cvt_pk_bf16(a[0], a[1]), cvt_pk_bf16(a[2], a[3]), cvt_pk_bf16(b[0], b[1]), cvt_pk_bf16(b[2], b[3])}; return as_bf16x8(w); }
#define MFMA16(a, b, c) __builtin_amdgcn_mfma_f32_16x16x32_bf16(a, b, c, 0, 0, 0)

struct BlkRegs { u32x4 k[4], v[4]; };
struct AttnSeq { const bf16_t* Q; const bf16_t* K; const bf16_t* V; int br, bh, d, r, nb0; };
__device__ __forceinline__ AttnSeq attn_run(Frame& F, int run) {
    AttnSeq q; q.br = run >> 8; const int rem = run & 255; q.bh = rem >> 4; const int x = rem & 15, dsh = 2 * q.br, rps = 16 >> dsh;
    q.d = 1 << dsh; q.r = x / rps; q.nb0 = 4 * (x % rps);
    const bf16_t* P = (const bf16_t*)(F.ws + WS_C);
    q.Q = P + (size_t)4 * T * 512 + (size_t)q.bh * SEQ * 128; q.K = P + (size_t)5 * T * 512 + (size_t)q.bh * SEQ * 128; q.V = P + (size_t)6 * T * 512 + (size_t)q.bh * SEQ * 128;
    return q;
}
__device__ __forceinline__ void blk_issue(Frame& F, const AttnSeq& q, int blk, BlkRegs& R) {
#pragma unroll
    for (int j = 0; j < 4; ++j) {
        const int c = F.tid + NTHR * j, row = c >> 4, ch = c & 15;
        const size_t off = ((size_t)(blk * 128 + row) * q.d + q.r) * 128 + ch * 8;
        R.k[j] = *(const u32x4*)(q.K + off); R.v[j] = *(const u32x4*)(q.V + off);
    }
}
__device__ __forceinline__ void blk_write(Frame& F, int slot, const BlkRegs& R) {
    LAS unsigned char* Kl = F.lds + slot * 32768; LAS unsigned char* Vl = F.lds + 65536 + slot * 32768;
#pragma unroll
    for (int j = 0; j < 4; ++j) {
        const int c = F.tid + NTHR * j, row = c >> 4, ch = c & 15;
        *(LAS u32x4*)(Kl + rr_off(row, ch)) = R.k[j]; *(LAS u32x4*)(Vl + tr_off(row, ch * 16)) = R.v[j];
    }
}
__device__ __forceinline__ void q_issue(Frame& F, const AttnSeq& q, int nb, bf16x8 (&qf)[4]) {
    const int lq = nb * 128 + 16 * F.wave + (F.lane & 15), g = F.lane >> 4;
#pragma unroll
    for (int ks = 0; ks < 4; ++ks) qf[ks] = *(const bf16x8*)(q.Q + ((size_t)lq * q.d + q.r) * 128 + 32 * ks + 8 * g);
}
__device__ __forceinline__ void attn_compute(Frame& F, const AttnSeq& q, int nb, int sp, const bf16x8 (&qf)[4]) {
    const int lane = F.lane, w = F.wave, i = lane & 15, g = lane >> 4;
    const int lq = nb * 128 + 16 * w + i;
    const float NEG = -__builtin_inff();
    int kof[4], vof[8];
#pragma unroll
    for (int ks = 0; ks < 4; ++ks) kof[ks] = i * 256 + (((4 * ks + g) ^ i) << 4);
    { const int rl = 4 * g + (i >> 2);
#pragma unroll
      for (int eb = 0; eb < 8; ++eb) vof[eb] = 65536 + rl * 256 + ((32 * eb + 8 * (i & 3)) ^ ((rl & 7) << 5)); }
    f32x4 sc[9];
    bf16x8 kf[2][4];
#define ATT_KB(kbi_) ((((w + (kbi_)) < 8) ? sp : (sp ^ 1)) * 32768 + ((w + (kbi_)) & 7) * 4096)
#define ATT_LDK(buf, kbi_) do { const int bo_ = ATT_KB(kbi_); _Pragma("unroll") for (int ks = 0; ks < 4; ++ks) kf[buf][ks] = *(const LAS bf16x8*)(F.lds + bo_ + kof[ks]); } while (0)
    ATT_LDK(0, 0);
#pragma unroll
    for (int kbi = 0; kbi < 9; ++kbi) {
        if (kbi + 1 < 9) ATT_LDK((kbi + 1) & 1, kbi + 1);
        f32x4 c = {0.f, 0.f, 0.f, 0.f};
#pragma unroll
        for (int ks = 0; ks < 4; ++ks) c = MFMA16(kf[kbi & 1][ks], qf[ks], c);
        sc[kbi] = c;
    }
#undef ATT_LDK
#pragma unroll
    for (int rg = 0; rg < 4; ++rg) { sc[0][rg] = (i <= 4 * g + rg) ? sc[0][rg] : NEG; sc[8][rg] = (i >= 4 * g + rg) ? sc[8][rg] : NEG; }
    if (nb == 0) {
#pragma unroll
        for (int kbi = 0; kbi < 8; ++kbi) if (w + kbi < 8) sc[kbi] = (f32x4){NEG, NEG, NEG, NEG};
    }
    float mx = fmaxf(fmaxf(sc[0][0], sc[0][1]), fmaxf(sc[0][2], sc[0][3]));
#pragma unroll
    for (int kbi = 1; kbi < 9; ++kbi) mx = fmaxf(mx, fmaxf(fmaxf(sc[kbi][0], sc[kbi][1]), fmaxf(sc[kbi][2], sc[kbi][3])));
    mx = fmaxf(mx, __shfl_xor(mx, 16)); mx = fmaxf(mx, __shfl_xor(mx, 32));
    const float mxl = -mx * 1.4426950408889634f;
    float den = 0.f;
#pragma unroll
    for (int kbi = 0; kbi < 9; ++kbi)
#pragma unroll
        for (int rg = 0; rg < 4; ++rg) { const float p = __builtin_amdgcn_exp2f(__builtin_fmaf(sc[kbi][rg], 1.4426950408889634f, mxl)); sc[kbi][rg] = p; den += p; }
    den += __shfl_xor(den, 16); den += __shfl_xor(den, 32);
    f32x4 o[8];
#pragma unroll
    for (int eb = 0; eb < 8; ++eb) o[eb] = (f32x4){0.f, 0.f, 0.f, 0.f};
    s16x4 vf[2][4][2];
#define ATT_LDV(buf, hs_) do { const int t_ = (hs_) >> 1, e0_ = 4 * ((hs_) & 1); const int b0_ = ATT_KB(2 * t_), b1_ = (2 * t_ + 1 < 9 && w + 2 * t_ + 1 <= 15) ? ATT_KB(2 * t_ + 1) : b0_; \
        _Pragma("unroll") for (int e = 0; e < 4; ++e) { vf[buf][e][0] = __builtin_amdgcn_ds_read_tr16_b64_v4i16((LAS s16x4*)(F.lds + b0_ + vof[e0_ + e])); \
                                                        vf[buf][e][1] = __builtin_amdgcn_ds_read_tr16_b64_v4i16((LAS s16x4*)(F.lds + b1_ + vof[e0_ + e])); } } while (0)
    ATT_LDV(0, 0);
#pragma unroll
    for (int hs = 0; hs < 10; ++hs) {
        if (hs + 1 < 10) ATT_LDV((hs + 1) & 1, hs + 1);
        const int t = hs >> 1;
        const f32x4 z = {0.f, 0.f, 0.f, 0.f};
        const bf16x8 pf = pack_f8(sc[2 * t], (2 * t + 1 < 9) ? sc[(2 * t + 1 < 9) ? 2 * t + 1 : 8] : z);
#pragma unroll
        for (int e = 0; e < 4; ++e) o[4 * (hs & 1) + e] = MFMA16(cat4(vf[hs & 1][e][0], vf[hs & 1][e][1]), pf, o[4 * (hs & 1) + e]);
    }
#undef ATT_LDV
#undef ATT_KB
    const float rden = __builtin_amdgcn_rcpf(den);
    const int tok = (q.bh >> 2) * SEQ + lq * q.d + q.r, h = q.bh & 3;
    bf16_t* ob = (bf16_t*)(F.ws + WS_OBR) + ((size_t)q.br * T + tok) * 512 + h * 128 + 4 * g;
#pragma unroll
    for (int eb = 0; eb < 8; ++eb) { const f32x4 v = o[eb] * rden; u32x2 wv = {cvt_pk_bf16(v[0], v[1]), cvt_pk_bf16(v[2], v[3])}; *(u32x2*)(ob + 16 * eb) = wv; }
    if (g == 0) ((float*)(F.ws + WS_LSE))[((size_t)q.br * T + tok) * 4 + h] = mx + __logf(den);
}
__device__ __forceinline__ void attn_all(Frame& F) {
    BlkRegs RA, RB; bf16x8 qn[4], qf[4];
    int run = F.vcu;
    if (run >= 768) return;
    AttnSeq q = attn_run(F, run);
    blk_issue(F, q, q.nb0 > 0 ? q.nb0 - 1 : 0, RA); blk_issue(F, q, q.nb0, RB); q_issue(F, q, q.nb0, qn);
    bool wrA = true;
    for (int j = 0;; ) {
        __syncthreads();
        if (wrA) blk_write(F, 1, RA);
        blk_write(F, j & 1, RB);
#pragma unroll
        for (int ks = 0; ks < 4; ++ks) { qf[ks] = qn[ks]; asm volatile("" : "+v"(qf[ks])); }
        __syncthreads();
        const AttnSeq qc = q; const int nb = q.nb0 + j, sp = (j & 1) ^ 1;
        bool more = true;
        if (j < 3) { blk_issue(F, q, nb + 1, RB); q_issue(F, q, nb + 1, qn); wrA = false; ++j; }
        else { run += F.G; if (run < 768) { q = attn_run(F, run); blk_issue(F, q, q.nb0 > 0 ? q.nb0 - 1 : 0, RA); blk_issue(F, q, q.nb0, RB); q_issue(F, q, q.nb0, qn); wrA = true; j = 0; } else more = false; }
        attn_compute(F, qc, nb, sp, qf);
        if (!more) break;
    }
}

__device__ __forceinline__ float ret_log2g(int h) { return log2f(1.0f - exp2f(-5.0f - (float)h)); }
__device__ __forceinline__ void kv_unit(Frame& F, int u) {
    const int bh = u >> 6, n = u & 63, h = bh & 3;
    const bf16_t* P = (const bf16_t*)(F.ws + WS_C);
    const bf16_t* Kg = P + (size_t)1 * T * 512 + ((size_t)bh * SEQ + n * 128) * 128;
    const bf16_t* Vg = P + (size_t)2 * T * 512 + ((size_t)bh * SEQ + n * 128) * 128;
    LAS unsigned char* Kl = F.lds; LAS unsigned char* Vl = F.lds + 32768;
    const int lane = F.lane, w = F.wave, i = lane & 15, g = lane >> 4;
    const float l2g = ret_log2g(h);
    u32x4 kr[4], vr[4];
#pragma unroll
    for (int j = 0; j < 4; ++j) { const int q = F.tid + NTHR * j; kr[j] = *(const u32x4*)(Kg + (size_t)q * 8); vr[j] = *(const u32x4*)(Vg + (size_t)q * 8); }
    __syncthreads();
#pragma unroll
    for (int j = 0; j < 4; ++j) {
        const int q = F.tid + NTHR * j, r = q >> 4, ch = q & 15;
        const float z = exp2f((float)(127 - r) * l2g);
        u32x4 o;
#pragma unroll
        for (int c = 0; c < 4; ++c) o[c] = cvt_pk_bf16(bflo(vr[j][c]) * z, bfhi(vr[j][c]) * z);
        *(LAS u32x4*)(Vl + tr_off(r, ch * 16)) = o;
        *(LAS u32x4*)(Kl + tr_off(r, ch * 16)) = kr[j];
    }
    __syncthreads();
    const int eb0 = 2 * (w & 3), db0 = 4 * (w >> 2);
    f32x4 acc[2][4];
#pragma unroll
    for (int a = 0; a < 2; ++a)
#pragma unroll
        for (int b = 0; b < 4; ++b) acc[a][b] = (f32x4){0.f, 0.f, 0.f, 0.f};
#pragma unroll
    for (int t = 0; t < 4; ++t) {
        bf16x8 af[2], bf[4];
#pragma unroll
        for (int a = 0; a < 2; ++a) af[a] = cat4(tr_frag(Vl, 2 * t, eb0 + a, i, g), tr_frag(Vl, 2 * t + 1, eb0 + a, i, g));
#pragma unroll
        for (int b = 0; b < 4; ++b) bf[b] = cat4(tr_frag(Kl, 2 * t, db0 + b, i, g), tr_frag(Kl, 2 * t + 1, db0 + b, i, g));
#pragma unroll
        for (int a = 0; a < 2; ++a)
#pragma unroll
            for (int b = 0; b < 4; ++b) acc[a][b] = MFMA16(bf[b], af[a], acc[a][b]);
    }
    bf16_t* kv = (bf16_t*)(F.ws + WS_KV) + (size_t)u * 16384;
#pragma unroll
    for (int a = 0; a < 2; ++a)
#pragma unroll
        for (int b = 0; b < 4; ++b) { u32x2 wv = {cvt_pk_bf16(acc[a][b][0], acc[a][b][1]), cvt_pk_bf16(acc[a][b][2], acc[a][b][3])};
            *(u32x2*)(kv + (16 * (eb0 + a) + i) * 128 + 16 * (db0 + b) + 4 * g) = wv; }
}

__device__ __forceinline__ void p3_scan(Frame& F) {
    const unsigned* kv = (const unsigned*)(F.ws + WS_KV); unsigned* st = (unsigned*)(F.ws + WS_ST);
    for (int q = F.vcu * NTHR + F.tid; q < 16 * 8192; q += F.G * NTHR) {
        const int bh = q >> 13, ep = q & 8191, h = bh & 3;
        const float dec = exp2f(128.0f * ret_log2g(h));
        const unsigned* src = kv + (size_t)bh * 64 * 8192 + ep; unsigned* dstp = st + (size_t)bh * 64 * 8192 + ep;
        float s0 = 0.f, s1 = 0.f;
#pragma unroll 16
        for (int n = 0; n < 64; ++n) { dstp[(size_t)n * 8192] = cvt_pk_bf16(s0, s1); const unsigned k = __builtin_nontemporal_load(src + (size_t)n * 8192); s0 = s0 * dec + bflo(k); s1 = s1 * dec + bfhi(k); }
    }
}

struct RetRegs { u32x4 tq[4], tk[4], tv[4], ts[4]; };
__device__ __forceinline__ void retout_issue(Frame& F, int u, RetRegs& R) {
    const bf16_t* P = (const bf16_t*)(F.ws + WS_C);
    const int bh = u >> 6, n = u & 63;
    const size_t hoff = ((size_t)bh * SEQ + n * 128) * 128;
    const bf16_t* sg = (const bf16_t*)(F.ws + WS_ST) + (size_t)u * 16384;
#pragma unroll
    for (int j = 0; j < 4; ++j) { const size_t q8 = (size_t)(F.tid + NTHR * j) * 8;
        R.tq[j] = __builtin_nontemporal_load((const u32x4*)(P + hoff + q8)); R.tk[j] = __builtin_nontemporal_load((const u32x4*)(P + (size_t)1 * T * 512 + hoff + q8));
        R.tv[j] = __builtin_nontemporal_load((const u32x4*)(P + (size_t)2 * T * 512 + hoff + q8)); R.ts[j] = __builtin_nontemporal_load((const u32x4*)(sg + q8)); }
}
__device__ __forceinline__ void retout_write(Frame& F, const RetRegs& R) {
    LAS unsigned char* Ql = F.lds; LAS unsigned char* Kl = F.lds + 32768; LAS unsigned char* Vl = F.lds + 65536; LAS unsigned char* Sl = F.lds + 98304;
#pragma unroll
    for (int j = 0; j < 4; ++j) { const int q = F.tid + NTHR * j, r = q >> 4, ch = q & 15;
        *(LAS u32x4*)(Ql + rr_off(r, ch)) = R.tq[j]; *(LAS u32x4*)(Kl + rr_off(r, ch)) = R.tk[j]; *(LAS u32x4*)(Vl + tr_off(r, ch * 16)) = R.tv[j]; *(LAS u32x4*)(Sl + rr_off(r, ch)) = R.ts[j]; }
}
__device__ __forceinline__ void retout_compute(Frame& F, int u) {
    const int bh = u >> 6, n = u & 63, h = bh & 3, b = bh >> 2;
    const bf16_t* P = (const bf16_t*)(F.ws + WS_C);
    const size_t hoff = ((size_t)bh * SEQ + n * 128) * 128;
    const LAS unsigned char* Ql = F.lds; const LAS unsigned char* Kl = F.lds + 32768; const LAS unsigned char* Vl = F.lds + 65536; const LAS unsigned char* Sl = F.lds + 98304;
    const int lane = F.lane, w = F.wave, i = lane & 15, g = lane >> 4;
    const float l2g = ret_log2g(h);
    bf16x8 qf[4];
#pragma unroll
    for (int ks = 0; ks < 4; ++ks) qf[ks] = rr_frag(Ql, 16 * w, ks, i, g);
    const int qi = 16 * w + i;
    f32x4 oi[8];
    { const float xi = exp2f((float)(qi + 1) * l2g);
      bf16x8 qx[4];
#pragma unroll
      for (int ks = 0; ks < 4; ++ks) { const u32x4 qw = *reinterpret_cast<const u32x4*>(&qf[ks]); u32x4 o;
#pragma unroll
          for (int c = 0; c < 4; ++c) o[c] = cvt_pk_bf16(bflo(qw[c]) * xi, bfhi(qw[c]) * xi);
          qx[ks] = as_bf16x8(o); }
#pragma unroll
      for (int eb = 0; eb < 8; ++eb) {
          f32x4 c = {0.f, 0.f, 0.f, 0.f};
#pragma unroll
          for (int ks = 0; ks < 4; ++ks) c = MFMA16(rr_frag(Sl, 16 * eb, ks, i, g), qx[ks], c);
          oi[eb] = c;
      } }
    for (int t = 0; 2 * t <= w; ++t) {
        f32x4 s0 = {0.f, 0.f, 0.f, 0.f}, s1 = {0.f, 0.f, 0.f, 0.f};
        const int jb0 = 2 * t, jb1 = 2 * t + 1;
#pragma unroll
        for (int ks = 0; ks < 4; ++ks) s0 = MFMA16(rr_frag(Kl, 16 * jb0, ks, i, g), qf[ks], s0);
        if (jb1 <= w) {
#pragma unroll
            for (int ks = 0; ks < 4; ++ks) s1 = MFMA16(rr_frag(Kl, 16 * jb1, ks, i, g), qf[ks], s1);
        }
#pragma unroll
        for (int rg = 0; rg < 4; ++rg) {
            const int d0 = qi - (16 * jb0 + 4 * g + rg), d1 = qi - (16 * jb1 + 4 * g + rg);
            s0[rg] = d0 >= 0 ? s0[rg] * exp2f((float)d0 * l2g) : 0.f;
            s1[rg] = d1 >= 0 ? s1[rg] * exp2f((float)d1 * l2g) : 0.f;
        }
        const bf16x8 pf = pack_f8(s0, s1);
#pragma unroll
        for (int eb = 0; eb < 8; ++eb) oi[eb] = MFMA16(cat4(tr_frag(Vl, jb0, eb, i, g), tr_frag(Vl, jb1, eb, i, g)), pf, oi[eb]);
    }
    float s = 0.f;
#pragma unroll
    for (int eb = 0; eb < 8; ++eb) s += (oi[eb][0] + oi[eb][1]) + (oi[eb][2] + oi[eb][3]);
    s += __shfl_xor(s, 16); s += __shfl_xor(s, 32);
    const float mean = s * (1.0f / 128.0f);
    float q2 = 0.f;
#pragma unroll
    for (int eb = 0; eb < 8; ++eb) { oi[eb] = oi[eb] - mean; q2 += (oi[eb][0] * oi[eb][0] + oi[eb][1] * oi[eb][1]) + (oi[eb][2] * oi[eb][2] + oi[eb][3] * oi[eb][3]); }
    q2 += __shfl_xor(q2, 16); q2 += __shfl_xor(q2, 32);
    const float rstd = 1.0f / sqrtf(q2 * (1.0f / 128.0f) + NORM_EPS);
    const bf16_t* gp = P + (size_t)3 * T * 512 + hoff + (size_t)qi * 128 + 4 * g;
    bf16_t* cp = (bf16_t*)(F.ws + WS_H) + ((size_t)(b * SEQ + n * 128 + qi)) * 1024 + h * 128 + 4 * g;
#pragma unroll
    for (int eb = 0; eb < 8; ++eb) {
        const u32x2 gv = *(const u32x2*)(gp + 16 * eb);
        const f32x4 y = oi[eb] * rstd;
        u32x2 wv = {cvt_pk_bf16(y[0] * bflo(gv[0]), y[1] * bfhi(gv[0])), cvt_pk_bf16(y[2] * bflo(gv[1]), y[3] * bfhi(gv[1]))};
        *(u32x2*)(cp + 16 * eb) = wv;
    }
}
__device__ __forceinline__ void retout_all(Frame& F) {
    RetRegs R;
    int u = F.vcu;
    if (u < 1024) retout_issue(F, u, R);
    while (u < 1024) {
        __syncthreads();
        retout_write(F, R);
        __syncthreads();
        const int un = u + F.G;
        if (un < 1024) retout_issue(F, un, R);
        retout_compute(F, u);
        u = un;
    }
}
__device__ __forceinline__ void combine_tokens(Frame& F) {
    const int gw = F.vcu * NWAVES + F.wave, NGW = F.G * NWAVES, lane = F.lane, h = lane >> 4;
    const bf16_t* ob = (const bf16_t*)(F.ws + WS_OBR); const float* lse = (const float*)(F.ws + WS_LSE);
    bf16_t* cat = (bf16_t*)(F.ws + WS_H);
    constexpr int NB = 4;
    for (int t0 = gw; t0 < T; t0 += NGW * NB) {
        float l[NB][3]; u32x4 v[NB][3];
#pragma unroll
        for (int b = 0; b < NB; ++b) { const int tok = min(t0 + b * NGW, T - 1);
#pragma unroll
            for (int br = 0; br < 3; ++br) { l[b][br] = lse[((size_t)br * T + tok) * 4 + h]; v[b][br] = __builtin_nontemporal_load((const u32x4*)(ob + ((size_t)br * T + tok) * 512 + lane * 8)); } }
#pragma unroll
        for (int b = 0; b < NB; ++b) { const int tok = t0 + b * NGW; if (tok >= T) break;
            const float m = fmaxf(l[b][0], fmaxf(l[b][1], l[b][2]));
            float w0 = __expf(l[b][0] - m), w1 = __expf(l[b][1] - m), w2 = __expf(l[b][2] - m); const float rs = 1.0f / (w0 + w1 + w2); w0 *= rs; w1 *= rs; w2 *= rs;
            u32x4 o;
#pragma unroll
            for (int j = 0; j < 4; ++j) o[j] = cvt_pk_bf16(w0 * bflo(v[b][0][j]) + w1 * bflo(v[b][1][j]) + w2 * bflo(v[b][2][j]), w0 * bfhi(v[b][0][j]) + w1 * bfhi(v[b][1][j]) + w2 * bfhi(v[b][2][j]));
            *(u32x4*)(cat + (size_t)tok * 1024 + 512 + lane * 8) = o; }
    }
}

__device__ __forceinline__ void p6_router(Frame& F) {
    LAS unsigned char* Whi = F.lds; LAS unsigned char* Wlo = F.lds + 65536;
    LAS unsigned char* misc = F.lds + MISC_OFF;
    LAS float* g2 = (LAS float*)(misc + MO_G2); LAS int* hist = (LAS int*)(misc + MO_HIST); LAS int* base = (LAS int*)(misc + MO_BASE);
    const int lane = F.lane, w = F.wave, i = lane & 15, g = lane >> 4;
    __syncthreads();
    {
        const u32x4* src = (const u32x4*)(F.ws + WS_WR); u32x4 t[16];
#pragma unroll
        for (int j = 0; j < 16; ++j) t[j] = src[F.tid + NTHR * j];
#pragma unroll
        for (int j = 0; j < 16; ++j) *(LAS u32x4*)(F.lds + (size_t)(F.tid + NTHR * j) * 16) = t[j];
    }
    for (int q = F.tid; q < 1024; q += NTHR) g2[q] = F.norm_ffn_g[q];
    if (F.tid < 32) hist[F.tid] = 0;
    __syncthreads();
    const bf16_t* x1 = (const bf16_t*)(F.ws + WS_X1); unsigned char* h2u = F.ws + WS_H;
    for (int grp = F.vcu; grp * 128 < T; grp += F.G) {
        const int tok = grp * 128 + 16 * w + i;
        const bf16_t* xr = x1 + (size_t)tok * 1024 + 16 * g;
        f32x4 acc[2] = {{0.f, 0.f, 0.f, 0.f}, {0.f, 0.f, 0.f, 0.f}};
        float ss = 0.f;
#pragma unroll 1
        for (int kp = 0; kp < 8; ++kp) {
            f32x16 pa, pb;
#pragma unroll
            for (int hh = 0; hh < 2; ++hh) {
                const int kb = 2 * kp + hh;
                f32x4 y[4];
                const u32x4 xa = *(const u32x4*)(xr + 64 * kb), xb = *(const u32x4*)(xr + 64 * kb + 8);
#pragma unroll
                for (int c = 0; c < 4; ++c) {
                    const unsigned w0 = (c < 2 ? xa : xb)[2 * (c & 1)], w1 = (c < 2 ? xa : xb)[2 * (c & 1) + 1];
                    const f32x4 xv = {bflo(w0), bfhi(w0), bflo(w1), bfhi(w1)}, gv = *(const LAS f32x4*)(g2 + 64 * kb + 16 * g + 4 * c);
                    ss += (xv[0] * xv[0] + xv[1] * xv[1]) + (xv[2] * xv[2] + xv[3] * xv[3]);
                    y[c] = xv * gv;
#pragma unroll
                    for (int j = 0; j < 4; ++j) { const float q = __builtin_amdgcn_fmed3f(y[c][j] * H6_SCALE, -7.5f, 7.5f); if (hh) pb[4 * c + j] = q; else pa[4 * c + j] = q; }
                }
#pragma unroll
                for (int st = 0; st < 2; ++st) {
                    const f32x4 ya = y[2 * st], yb = y[2 * st + 1];
                    u32x4 hw = {cvt_pk_bf16(ya[0], ya[1]), cvt_pk_bf16(ya[2], ya[3]), cvt_pk_bf16(yb[0], yb[1]), cvt_pk_bf16(yb[2], yb[3])};
                    const f32x4 ra = {ya[0] - bflo(hw[0]), ya[1] - bfhi(hw[0]), ya[2] - bflo(hw[1]), ya[3] - bfhi(hw[1])};
                    const f32x4 rb = {yb[0] - bflo(hw[2]), yb[1] - bfhi(hw[2]), yb[2] - bflo(hw[3]), yb[3] - bfhi(hw[3])};
                    const bf16x8 yh = as_bf16x8(hw), yl = pack_f8(ra, rb);
#pragma unroll
                    for (int eb = 0; eb < 2; ++eb) {
                        const int off = (16 * eb + i) * 2048 + (((8 * kb + 2 * g + st) ^ i) << 4);
                        const bf16x8 wh = *(const LAS bf16x8*)(Whi + off), wl = *(const LAS bf16x8*)(Wlo + off);
                        acc[eb] = MFMA16(wh, yh, acc[eb]); acc[eb] = MFMA16(wh, yl, acc[eb]); acc[eb] = MFMA16(wl, yh, acc[eb]);
                    }
                }
            }
            const u32x6 q6 = __builtin_amdgcn_cvt_scalef32_2xpk16_fp6_f32(pa, pb, 1.0f);
            unsigned char* hp = h2u + (size_t)tok * 1024 + 128 * kp + 16 * g;
            *(u32x4*)hp = (u32x4){q6[0], q6[1], q6[2], q6[3]};
            *(u32x4*)(hp + 64) = (u32x4){q6[4], q6[5], 0u, 0u};
        }
        ss += __shfl_xor(ss, 16); ss += __shfl_xor(ss, 32);
        const float rstd = 1.0f / sqrtf(ss * (1.0f / 1024.0f) + NORM_EPS);
        float lg[32];
#pragma unroll
        for (int eb = 0; eb < 2; ++eb)
#pragma unroll
            for (int rg = 0; rg < 4; ++rg) {
                const float v = acc[eb][rg] * rstd;
#pragma unroll
                for (int gg = 0; gg < 4; ++gg) lg[16 * eb + 4 * gg + rg] = __shfl(v, 16 * gg + i);
            }
#pragma unroll
        for (int e = 0; e < 32; ++e) lg[e] += F.b_router[e];
        float tv[4]; int ti[4];
#pragma unroll
        for (int k = 0; k < 4; ++k) {
            float bv = -__builtin_inff(); int bi = 0;
#pragma unroll
            for (int e = 0; e < 32; ++e) { const bool gt = lg[e] > bv; bv = gt ? lg[e] : bv; bi = gt ? e : bi; }
            tv[k] = bv; ti[k] = bi;
#pragma unroll
            for (int e = 0; e < 32; ++e) lg[e] = (e == bi) ? -__builtin_inff() : lg[e];
        }
        float gsum = 0.f, gt4[4];
#pragma unroll
        for (int k = 0; k < 4; ++k) { gt4[k] = __expf(tv[k] - tv[0]); gsum += gt4[k]; }
        int my_e = ti[0]; float my_g = gt4[0];
#pragma unroll
        for (int k = 1; k < 4; ++k) { my_e = (g == k) ? ti[k] : my_e; my_g = (g == k) ? gt4[k] : my_g; }
        my_g /= gsum;
        const int lrank = atomicAdd((int*)(hist + my_e), 1);
        __syncthreads();
        if (F.tid < 32) { base[F.tid] = (int)atomicAdd(F.ctl + CW_CNT + 64 * F.tid, (unsigned)hist[F.tid]); }
        __syncthreads();
        const int rank = base[my_e] + lrank;
        ((int*)(F.ws + WS_RTOK))[(size_t)my_e * T + rank] = tok;
        ((float*)(F.ws + WS_RGATE))[(size_t)my_e * T + rank] = my_g;
        ((float*)(F.ws + WS_RRSTD))[(size_t)my_e * T + rank] = rstd;
        ((int*)(F.ws + WS_SLOT))[tok * 4 + g] = my_e * T + rank;
        __syncthreads();
        if (F.tid < 32) hist[F.tid] = 0;
        __syncthreads();
    }
}

__device__ __forceinline__ void p9_final(Frame& F) {
    LAS unsigned char* misc = F.lds + MISC_OFF; const LAS int* tp = (const LAS int*)(misc + MO_TP);
    const int gw = F.vcu * NWAVES + F.wave, NGW = F.G * NWAVES, lane = F.lane;
    const bf16_t* x1 = (const bf16_t*)(F.ws + WS_X1); const unsigned char* yb = F.ws + WS_D; const int* slot = (const int*)(F.ws + WS_SLOT);
    f32x4 gv[4];
#pragma unroll
    for (int j = 0; j < 4; ++j) gv[j] = *((const f32x4*)F.norm_final_g + lane + 64 * j);
    constexpr int NB = 4;
    for (int t0 = gw; t0 < T; t0 += NGW * NB) {
        int sl[NB][4];
#pragma unroll
        for (int b = 0; b < NB; ++b) { const int tok = min(t0 + b * NGW, T - 1);
#pragma unroll
            for (int k = 0; k < 4; ++k) sl[b][k] = slot[tok * 4 + k]; }
        f32x4 v[NB][4]; unsigned y[NB][4][4];
#pragma unroll
        for (int b = 0; b < NB; ++b) { const int tok = min(t0 + b * NGW, T - 1);
#pragma unroll
            for (int j = 0; j < 4; ++j) { const u32x2 xw = __builtin_nontemporal_load((const u32x2*)(x1 + (size_t)tok * 1024) + lane + 64 * j); v[b][j] = (f32x4){bflo(xw[0]), bfhi(xw[0]), bflo(xw[1]), bfhi(xw[1])}; }
#pragma unroll
            for (int k = 0; k < 4; ++k) { const int e = sl[b][k] >> 15, rank = sl[b][k] & 32767; const size_t row = (size_t)tp[e] * 256 + rank;
                const unsigned* yr = (const unsigned*)(yb + row * 1024) + lane;
#pragma unroll
                for (int j = 0; j < 4; ++j) y[b][k][j] = __builtin_nontemporal_load(yr + 64 * j); } }
#pragma unroll
        for (int b = 0; b < NB; ++b) { const int tok = t0 + b * NGW; if (tok >= T) break;
#pragma unroll
            for (int k = 0; k < 4; ++k)
#pragma unroll
                for (int j = 0; j < 4; ++j) { const f32x2 lo = __builtin_amdgcn_cvt_pk_f32_fp8((int)y[b][k][j], false), hi = __builtin_amdgcn_cvt_pk_f32_fp8((int)y[b][k][j], true);
                    v[b][j][0] += lo[0] * (1.0f / YB8_SCALE); v[b][j][1] += lo[1] * (1.0f / YB8_SCALE); v[b][j][2] += hi[0] * (1.0f / YB8_SCALE); v[b][j][3] += hi[1] * (1.0f / YB8_SCALE); }
            float ssum = 0.f;
#pragma unroll
            for (int j = 0; j < 4; ++j) ssum += (v[b][j][0] * v[b][j][0] + v[b][j][1] * v[b][j][1]) + (v[b][j][2] * v[b][j][2] + v[b][j][3] * v[b][j][3]);
            const float rstd = 1.0f / sqrtf(wave_sum(ssum) * (1.0f / 1024.0f) + NORM_EPS);
#pragma unroll
            for (int j = 0; j < 4; ++j) __builtin_nontemporal_store(v[b][j] * rstd * gv[j], (f32x4*)(F.out + (size_t)tok * 1024) + lane + 64 * j); }
    }
}

__global__ void __launch_bounds__(NTHR, 2) hybrid_fwd(Args args) {
    extern __shared__ __attribute__((aligned(16))) unsigned char lds_raw[];
    Frame F;
    F.lds = (LAS unsigned char*)lds_raw;
    F.tid = threadIdx.x; F.lane = F.tid & 63; F.wave = __builtin_amdgcn_readfirstlane(F.tid >> 6);
    F.G = gridDim.x; { const int bx = blockIdx.x; F.vcu = (F.G % 8 == 0) ? (bx % 8) * (F.G / 8) + bx / 8 : bx; }
    F.x = args.in[0]; F.norm_mix_g = args.in[1]; F.w_in = args.in[2]; F.w_out = args.in[3]; F.norm_ffn_g = args.in[4]; F.w_router = args.in[5]; F.b_router = args.in[6];
    F.w_gu = args.in[7]; F.b_gu = args.in[8]; F.w_dn = args.in[9]; F.b_dn = args.in[10]; F.norm_final_g = args.in[11];
    F.out = args.out; F.ws = args.ws; F.ctl = (unsigned*)(args.ws + WS_CTL);
    const int lo = args.ph_lo, hi = args.ph_hi;
    if (F.tid < 4) ((LAS unsigned*)(F.lds + MISC_OFF + MO_BAR))[F.tid] = 0u;
    __syncthreads();
    XcdBarrier bar; bar.bar = F.ctl + CW_BAR; bar.x = 0; bar.st = (volatile LAS unsigned*)(F.lds + MISC_OFF + MO_BAR);
    if (hi - lo > 1) bar = xcd_barrier_post(F.ctl + CW_BAR, (volatile LAS unsigned*)(F.lds + MISC_OFF + MO_BAR));
#define IN(k) (lo <= (k) && (k) < hi)
#define SEAM(k) do { if (IN(k) && IN((k) + 1)) xcd_barrier(bar); } while (0)

#define PHASE(k, ...) if (IN(k)) { { constexpr bool kRep = false; constexpr int kMode = 0; (void)kRep; (void)kMode; __VA_ARGS__ } if (REP_PH == (k)) { constexpr bool kRep = (REP_NOEPI != 0); constexpr int kMode = REP_NOEPI; (void)kRep; (void)kMode; __VA_ARGS__ } }
    PHASE(0, p0_prologue(F); )
    SEAM(0);
    PHASE(1, {
        const int bx = (int)blockIdx.x, qg = bx >> 3; const bool conv_only = (F.G == 256) && ((qg & 7) == 0);
        if (!conv_only) {
            const int Gg = (F.G == 256) ? 224 : F.G, cg = (F.G == 256) ? ((qg - (qg >> 3) - 1) * 8 + (bx & 7)) : bx;
            ProjProb S; S.so.init(T, DIN, Gg, cg); S.A = (const char*)(F.ws + WS_H); S.Bt = (const char*)(F.ws + WS_WIN); S.dst = (bf16_t*)(F.ws + WS_C);
            S.rt = (const unsigned*)(F.ws + WS_ROPE); S.misc = F.lds + MISC_OFF;
            {
                LAS unsigned* ta = (LAS unsigned*)(F.lds + MISC_OFF + MO_G2); LAS unsigned* tbb = (LAS unsigned*)(F.lds + MISC_OFF + MO_ROPEB);
                for (int q = F.tid; q < 1024; q += NTHR) { ta[q] = S.rt[q]; tbb[q] = S.rt[(q >> 6) * 1024 + (q & 63)]; }
                __syncthreads();
            }
            const int kbrk = 1 + (cg & 7);
            for (int part = 0; part < 2; ++part) {
                S.i0 = part ? kbrk : 0; S.i1 = part ? (1 << 30) : kbrk;
                pg8::gemm_phase<ProjProb, kRep>(F.lds, S);
                if (part == 0 && !kRep && kMode == 0) { conv_loop<true>(F); __syncthreads(); }
            }
        }
        if (!kRep && kMode == 0) conv_loop<false>(F); })
    SEAM(1);
    PHASE(2, {
        if (kMode != 2) attn_all(F);
        if (kMode != 1) for (int u = F.vcu; u < 1024; u += F.G) kv_unit(F, u);
        __syncthreads(); })
    SEAM(2);
    PHASE(3, p3_scan(F); )
    SEAM(3);
    PHASE(4, {
        if (kMode != 2) retout_all(F);
        if (kMode != 1) combine_tokens(F);
        __syncthreads(); })
    SEAM(4);
    PHASE(5, {
        OutProb S; S.so.init(T, DM, F.G, (int)blockIdx.x); S.A = (const char*)(F.ws + WS_H); S.Bt = (const char*)(F.ws + WS_WOUT); S.x = F.x; S.x1 = (bf16_t*)(F.ws + WS_X1);
        pg8::gemm_phase<OutProb, kRep>(F.lds, S); })
    SEAM(5);
    if (IN(6)) { p6_router(F); }
    SEAM(6);
    PHASE(7, {
        moe_tables(F);
        GuProb S; S.misc = F.lds + MISC_OFF; S.G = F.G; S.vcu = F.vcu; S.A = (const char*)(F.ws + WS_H); S.Bt = (const char*)(F.ws + WS_WGU);
        S.rtok = (const int*)(F.ws + WS_RTOK); S.rrstd = (const float*)(F.ws + WS_RRSTD); S.bias = F.b_gu; S.act = F.ws + WS_C;
        pg8::gemm_phase<GuProb, kRep>(F.lds, S); })
    SEAM(7);
    PHASE(8, {
        moe_tables(F);
        DnProb S; S.misc = F.lds + MISC_OFF; S.G = F.G; S.vcu = F.vcu; S.A = (const char*)(F.ws + WS_C); S.Bt = (const char*)(F.ws + WS_WDN);
        S.rgate = (const float*)(F.ws + WS_RGATE); S.bias = F.b_dn; S.yb = F.ws + WS_D;
        pg8::gemm_phase<DnProb, kRep>(F.lds, S); })
    SEAM(8);
    PHASE(9, { moe_tables(F); p9_final(F); })
#undef PHASE
#undef IN
#undef SEAM
}

extern "C" void kernel_launch(void* const* d_in, const int* in_sizes, int n_in, void* d_out, int out_size, void* d_ws, size_t ws_size, hipStream_t stream) {
    static int grid = 0;
    if (grid == 0) {
        if (n_in != 12 || out_size != T * DM || ws_size < WS_END) { fprintf(stderr, "kernel_launch: unexpected shapes (n_in %d out %d ws %zu)\n", n_in, out_size, ws_size); grid = -1; return; }
        int dev = 0, cus = 0, per_cu = 0;
        if (hipGetDevice(&dev) != hipSuccess || hipDeviceGetAttribute(&cus, hipDeviceAttributeMultiprocessorCount, dev) != hipSuccess) { grid = -1; return; }
        if (hipFuncSetAttribute((const void*)hybrid_fwd, hipFuncAttributeMaxDynamicSharedMemorySize, LDS_BYTES) != hipSuccess) { fprintf(stderr, "kernel_launch: hipFuncSetAttribute failed\n"); grid = -1; return; }
        if (hipOccupancyMaxActiveBlocksPerMultiprocessor(&per_cu, (const void*)hybrid_fwd, NTHR, LDS_BYTES) != hipSuccess || per_cu < 1) fprintf(stderr, "kernel_launch: occupancy query says %d\n", per_cu);
        (void)hipGetLastError();
        grid = cus;
    }
    if (grid < 0) return;
    (void)hipMemsetAsync((char*)d_ws + WS_CTL, 0, CTL_BYTES, stream);
    Args a{};
    for (int i = 0; i < 12; ++i) a.in[i] = (const float*)d_in[i];
    a.out = (float*)d_out; a.ws = (unsigned char*)d_ws;
    if (MK_N_LAUNCHES == 1) {
        a.ph_lo = 0; a.ph_hi = NPH;
        hipLaunchKernelGGL(hybrid_fwd, dim3(grid), dim3(NTHR), LDS_BYTES, stream, a);
    } else {
        for (int p = 0; p < NPH; ++p) { a.ph_lo = p; a.ph_hi = p + 1; hipLaunchKernelGGL(hybrid_fwd, dim3(grid), dim3(NTHR), LDS_BYTES, stream, a); }
    }
}
```

```cpp
#include <hip/hip_runtime.h>
#include <cstdio>
#include <cstdint>

#ifndef MK_N_LAUNCHES
#define MK_N_LAUNCHES 1
#endif

#ifndef REP_NOEPI
#define REP_NOEPI 0
#endif
#ifndef REP_PH
#define REP_PH (-1)
#endif

#define LAS __attribute__((address_space(3)))
#define GAS __attribute__((address_space(1)))
typedef unsigned short bf16_t;
typedef short bf16x8 __attribute__((ext_vector_type(8)));
typedef short s16x4 __attribute__((ext_vector_type(4)));
typedef float f32x4 __attribute__((ext_vector_type(4)));
typedef float f32x2 __attribute__((ext_vector_type(2)));
typedef unsigned u32x4 __attribute__((ext_vector_type(4)));
typedef unsigned u32x2 __attribute__((ext_vector_type(2)));
typedef int i32x8 __attribute__((ext_vector_type(8)));
typedef int i32x4 __attribute__((ext_vector_type(4)));
typedef int i32x6 __attribute__((ext_vector_type(6)));
typedef int i32x2 __attribute__((ext_vector_type(2)));
typedef unsigned u32x6 __attribute__((ext_vector_type(6)));
typedef float f32x16 __attribute__((ext_vector_type(16)));

constexpr int BATCH = 4, SEQ = 8192, DM = 1024, T = BATCH * SEQ, DIN = 3584, NEXP = 32;
constexpr int NWAVES = 8, NTHR = 512;
constexpr int MT_MAX = 544, PMAX = MT_MAX * 256;
constexpr float NORM_EPS = 1e-5f;
constexpr int NPH = 10;

constexpr size_t MiB = 1u << 20;
constexpr size_t WS_CTL = 0, CTL_BYTES = 128 * 1024;
constexpr size_t WS_ROPE = 1 * MiB;
constexpr size_t WS_WR = 3 * MiB;
constexpr size_t WS_WIN = 5 * MiB, WS_WOUT = 12 * MiB, WS_WGU = 14 * MiB, WS_WDN = 142 * MiB;
constexpr size_t WS_H = 206 * MiB;
constexpr size_t WS_X1 = 270 * MiB;
constexpr size_t WS_C = 398 * MiB;
constexpr size_t WS_D = 670 * MiB;
constexpr size_t WS_KV = WS_D, WS_ST = WS_D + 64 * MiB, WS_OBR = WS_D + 96 * MiB, WS_LSE = WS_D + 192 * MiB;
constexpr size_t WS_RT = 942 * MiB;
constexpr size_t WS_RTOK = WS_RT, WS_RGATE = WS_RT + 4 * MiB, WS_RRSTD = WS_RT + 8 * MiB, WS_SLOT = WS_RT + 12 * MiB;
constexpr size_t WS_END = 956 * MiB;
constexpr int CW_BAR = 4096;
constexpr int CW_CNT = 16384;
constexpr int CW_CONV6 = 24576;
constexpr int CW_CONV = 20480;

constexpr int RING_BYTES = 131072;
constexpr int MISC_OFF = RING_BYTES;
constexpr int LDS_BYTES = 147456;
constexpr int MO_BAR = 0;
constexpr int MO_CNT = 64;
constexpr int MO_TP = 256;
constexpr int MO_TE = 512;
constexpr int MO_HIST = 1280;
constexpr int MO_BASE = 1536;
constexpr int MO_G2 = 4096;
constexpr int MO_ROPEB = 12288;
constexpr int MO_EPI = 8192;

typedef __bf16 bf16x2_t __attribute__((ext_vector_type(2)));
__device__ __forceinline__ unsigned cvt_pk_bf16(float lo, float hi) { const bf16x2_t v = {(__bf16)lo, (__bf16)hi}; return __builtin_bit_cast(unsigned, v); }
__device__ __forceinline__ float bf2f(unsigned short b) { return __uint_as_float(((unsigned)b) << 16); }
__device__ __forceinline__ float bflo(unsigned w) { return __uint_as_float(w << 16); }
__device__ __forceinline__ float bfhi(unsigned w) { return __uint_as_float(w & 0xffff0000u); }
__device__ __forceinline__ float h2f_lo(unsigned w) { return (float)__builtin_bit_cast(_Float16, (unsigned short)(w & 0xffffu)); }
__device__ __forceinline__ float h2f_hi(unsigned w) { return (float)__builtin_bit_cast(_Float16, (unsigned short)(w >> 16)); }
__device__ __forceinline__ float clamp448(float v) { return __builtin_amdgcn_fmed3f(v, -448.0f, 448.0f); }
__device__ __forceinline__ unsigned pk4_fp8(float a, float b, float c, float d) {
    int w = __builtin_amdgcn_cvt_pk_fp8_f32(a, b, 0, false); w = __builtin_amdgcn_cvt_pk_fp8_f32(c, d, w, true); return (unsigned)w; }
constexpr float W6_SCALE = 64.0f, H6_SCALE = 1.5f;
constexpr float W8_SCALE = 64.0f, ACT8_SCALE = 4.0f, YB8_SCALE = 16.0f;
#define LDS_WAIT() asm volatile("s_waitcnt lgkmcnt(0)" ::: "memory")
#define VM_WAIT() asm volatile("s_waitcnt vmcnt(0)" ::: "memory")
__device__ __forceinline__ float wave_sum(float v) {
#pragma unroll
    for (int o = 1; o < 64; o <<= 1) v += __shfl_xor(v, o);
    return v;
}
__device__ __forceinline__ bf16x8 as_bf16x8(u32x4 w) { return *reinterpret_cast<bf16x8*>(&w); }

#define XB_TMO      128
#define XB_XCNT(j)  (256  + 64 * (j))
#define XB_XSUB(j)  (1280 + 64 * (j))
#define XB_XGEN(j)  (2304 + 64 * (j))
#define XB_TOP      3328
#define XB_TOPGEN   3392
#define XCD_BAR_WORDS 3456
#define XB_SPIN_CAP (1u << 18)
__device__ __forceinline__ unsigned xb_ld(unsigned* p)              { return __hip_atomic_load(p, __ATOMIC_RELAXED, __HIP_MEMORY_SCOPE_AGENT); }
__device__ __forceinline__ unsigned xb_add(unsigned* p, unsigned v) { return __hip_atomic_fetch_add(p, v, __ATOMIC_RELAXED, __HIP_MEMORY_SCOPE_AGENT); }
__device__ __forceinline__ unsigned xb_xcc_id() { return (unsigned)__builtin_amdgcn_s_getreg((3 << 11) | 20) & 0xFu; }
#define XB_SPIN(cond, bar) do { unsigned _sp = 0; while (cond) { __builtin_amdgcn_s_sleep(1); \
    if ((++_sp & 255u) == 0u) { if (xb_ld(&(bar)[XB_TMO])) break; if (_sp > XB_SPIN_CAP) { atomicAdd(&(bar)[XB_TMO], 1u); break; } } } } while (0)
struct XcdBarrier { unsigned* bar; unsigned x; volatile LAS unsigned* st; };
__device__ __forceinline__ XcdBarrier xcd_barrier_post(unsigned* bar, volatile LAS unsigned* st) {
    XcdBarrier b; b.bar = bar; b.x = xb_xcc_id(); b.st = st;
    if (threadIdx.x == 0) (void)xb_add(&bar[XB_XCNT(b.x)], 1u);
    return b;
}
__device__ __forceinline__ void xcd_barrier_complete(unsigned* bar, unsigned x, unsigned& nloc, unsigned& nx) {
    const unsigned G = gridDim.x * gridDim.y * gridDim.z;
    unsigned sum, cnt, mine, sp = 0u;
    for (;;) {
        sum = 0u; cnt = 0u; mine = 0u;
#pragma unroll
        for (unsigned j = 0; j < 16; ++j) { const unsigned c = xb_ld(&bar[XB_XCNT(j)]); sum += c; cnt += (c > 0u) ? 1u : 0u; mine = (j == x) ? c : mine; }
        if (sum == G) break;
        __builtin_amdgcn_s_sleep(1);
        if ((++sp & 255u) == 0u) { if (xb_ld(&bar[XB_TMO])) break; if (sp > XB_SPIN_CAP) { atomicAdd(&bar[XB_TMO], 1u); break; } }
    }
    nloc = mine > 0u ? mine : 1u; nx = cnt > 0u ? cnt : 1u;
}
__device__ __forceinline__ void xcd_barrier(const XcdBarrier& b) {
    asm volatile("s_waitcnt vmcnt(0)" ::: "memory");
    __syncthreads();
    if (threadIdx.x == 0) {
        unsigned* bar = b.bar;
        __builtin_amdgcn_s_waitcnt(0);
        unsigned nloc = b.st[0], nx = b.st[1];
        if (nloc == 0u) { xcd_barrier_complete(bar, b.x, nloc, nx); b.st[0] = nloc; b.st[1] = nx; }
        const unsigned old = xb_add(&bar[XB_XSUB(b.x)], 1u);
        const unsigned gen = old / nloc;
        if (old + 1u == (gen + 1u) * nloc) {
            __builtin_amdgcn_fence(__ATOMIC_RELEASE, "agent");
            asm volatile("s_waitcnt vmcnt(0)" ::: "memory");
            const unsigned og = xb_add(&bar[XB_TOP], 1u);
            const unsigned tg = og / nx;
            if (og + 1u == (tg + 1u) * nx) xb_add(&bar[XB_TOPGEN], 1u);
            else XB_SPIN(xb_ld(&bar[XB_TOPGEN]) == tg, bar);
            __builtin_amdgcn_fence(__ATOMIC_ACQUIRE, "agent");
            xb_add(&bar[XB_XGEN(b.x)], 1u);
            asm volatile("s_waitcnt vmcnt(0)" ::: "memory");
        } else {
            XB_SPIN(xb_ld(&bar[XB_XGEN(b.x)]) == gen, bar);
            __builtin_amdgcn_fence(__ATOMIC_ACQUIRE, "agent");
            asm volatile("s_waitcnt vmcnt(0)" ::: "memory");
        }
    }
    __syncthreads();
}

namespace pg8 {
constexpr int BM = 256, BK = 64, HALF = 128, HTB = HALF * BK * 2, NXCD = 8, WGM = 4, KD = 1024, NKT = KD / BK;
__device__ __forceinline__ int lds_byte(int r, int c) { const int st = (r >> 4) * 2 + (c >> 5), rr = r & 15, cc = c & 31, ob = rr * 64 + cc * 2; return st * 1024 + (ob ^ (((ob >> 9) & 1) << 5)); }
__device__ __forceinline__ void stage_rc(int b, int& R, int& C) { const int st = b / 1024, sb = b % 1024, swz = sb ^ (((sb >> 9) & 1) << 5); R = (st >> 1) * 16 + swz / 64; C = (st & 1) * 32 + (swz % 64) / 2; }
__device__ __forceinline__ int perm32(int rho) { const int n = rho >> 4, i = rho & 15; return 8 * (i >> 2) + 4 * n + (i & 3); }

struct StaticOrder {
    int nM, nN, nwg, G, c;
    __device__ void init(int M, int N, int G_, int c_) { nM = M / BM; nN = N / BM; nwg = nM * nN; G = G_; c = c_; }
    __device__ bool next(int i, int& pm, int& pn) const {
        const long L = (long)i * G + c; if (L >= nwg) return false;
        int wgid = (int)L; { const int q = nwg / NXCD, r = nwg % NXCD, xcd = wgid % NXCD, off = wgid / NXCD; wgid = (xcd < r ? xcd * (q + 1) : r * (q + 1) + (xcd - r) * q) + off; }
        const int nig = WGM * nN, gid = wgid / nig, fm = gid * WGM, gsz = (nM - fm) < WGM ? (nM - fm) : WGM;
        pm = fm + ((wgid % nig) % gsz); pn = (wgid % nig) / gsz; return true;
    }
};

template <bool SIX> struct FragOf { typedef i32x8 type; };
template <> struct FragOf<true> { typedef i32x6 type; };
template <int H> __device__ __forceinline__ bf16x8 half8(i32x8 v) { const i32x4 h = H ? __builtin_shufflevector(v, v, 4, 5, 6, 7) : __builtin_shufflevector(v, v, 0, 1, 2, 3); return *reinterpret_cast<const bf16x8*>(&h); }
template <class P, bool NOEPI = false>
__device__ __forceinline__ void gemm_phase(LAS unsigned char* lds, const P& S) {
    typedef typename P::U Unit;
    const int tid = threadIdx.x, wid = __builtin_amdgcn_readfirstlane(tid >> 6), lane = tid & 63, wr = wid >> 2, wc = wid & 3, fr = lane & 15, fq = lane >> 4;
    constexpr bool ZI = P::ZINIT;
    constexpr bool F8 = P::FP8, F6 = P::FP6;
    constexpr int PB = F8 ? 1024 : 2048, nt = F8 ? 8 : 16;
    int R0, C0, R1, C1; stage_rc(tid * 16, R0, C0); stage_rc(tid * 16 + 8192, R1, C1);
    unsigned voffB[2];
    { const int Rb0 = P::PERM ? ((R0 & ~31) + perm32(R0 & 31)) : R0, Rb1 = P::PERM ? ((R1 & ~31) + perm32(R1 & 31)) : R1;
      voffB[0] = (unsigned)(Rb0 * PB + C0 * 2); voffB[1] = (unsigned)(Rb1 * PB + C1 * 2); }
    constexpr size_t kstep = (size_t)(BK * 2);
    constexpr size_t hstep = (size_t)HALF * PB;
    const unsigned ldsw = (unsigned)wid * 1024u;
    const int aoff = lds_byte(wr * 64 + fr, fq * 8), boff = lds_byte(wc * 32 + fr, fq * 8);
#define PG8_SA(b, h) (((b) * 2 + (h)) * HTB)
#define PG8_SB(b, h) ((4 + (b) * 2 + (h)) * HTB)
#define PG8_STAGE(bufoff, gbase, voff) do { _Pragma("unroll") for (int _i = 0; _i < 2; ++_i) \
        __builtin_amdgcn_global_load_lds((const unsigned*)((const char*)(gbase) + (voff)[_i]), (LAS unsigned*)(lds + (bufoff) + ldsw + _i * 8192), 16, 0, 0); } while (0)
#define PG8_LDA(dst, b, h) do { _Pragma("unroll") for (int m = 0; m < 4; ++m) { const i32x4 _lo = *(const LAS i32x4*)(lds + PG8_SA(b, h) + aoff + m * 2048); \
        if constexpr (F6) { const i32x2 _h2 = *(const volatile LAS i32x2*)(lds + PG8_SA(b, h) + aoff + m * 2048 + 1024); const i32x4 _hi = __builtin_shufflevector(_h2, _h2, 0, 1, -1, -1); dst[m] = __builtin_shufflevector(_lo, _hi, 0, 1, 2, 3, 4, 5); } \
        else { const i32x4 _hi = *(const LAS i32x4*)(lds + PG8_SA(b, h) + aoff + m * 2048 + 1024); dst[m] = __builtin_shufflevector(_lo, _hi, 0, 1, 2, 3, 4, 5, 6, 7); } } } while (0)
#define PG8_LDB(dst, b, h) do { _Pragma("unroll") for (int n = 0; n < 2; ++n) { const i32x4 _lo = *(const LAS i32x4*)(lds + PG8_SB(b, h) + boff + n * 2048); \
        if constexpr (F6) { const i32x2 _h2 = *(const volatile LAS i32x2*)(lds + PG8_SB(b, h) + boff + n * 2048 + 1024); const i32x4 _hi = __builtin_shufflevector(_h2, _h2, 0, 1, -1, -1); dst[n] = __builtin_shufflevector(_lo, _hi, 0, 1, 2, 3, 4, 5); } \
        else { const i32x4 _hi = *(const LAS i32x4*)(lds + PG8_SB(b, h) + boff + n * 2048 + 1024); dst[n] = __builtin_shufflevector(_lo, _hi, 0, 1, 2, 3, 4, 5, 6, 7); } } } while (0)
#define PG8_MMA(ai, bj, At, Bt) do { __builtin_amdgcn_s_setprio(1); _Pragma("unroll") for (int m = 0; m < 4; ++m) _Pragma("unroll") for (int n = 0; n < 2; ++n) { \
        if constexpr (F6) { asm volatile("v_mfma_f32_16x16x128_f8f6f4 %0, %1, %2, %0 cbsz:2 blgp:2" : "+v"(acc[ai][bj][m][n]) : "v"(Bt[n]), "v"(At[m])); } \
        else if constexpr (F8) { asm volatile("v_mfma_f32_16x16x128_f8f6f4 %0, %1, %2, %0" : "+v"(acc[ai][bj][m][n]) : "v"(Bt[n]), "v"(At[m])); } \
        else { acc[ai][bj][m][n] = __builtin_amdgcn_mfma_f32_16x16x32_bf16(half8<0>(Bt[n]), half8<0>(At[m]), acc[ai][bj][m][n], 0, 0, 0); \
               acc[ai][bj][m][n] = __builtin_amdgcn_mfma_f32_16x16x32_bf16(half8<1>(Bt[n]), half8<1>(At[m]), acc[ai][bj][m][n], 0, 0, 0); } } \
        __builtin_amdgcn_s_setprio(0); } while (0)
#define PG8_MMA0(ai, bj, At, Bt) do { __builtin_amdgcn_s_setprio(1); _Pragma("unroll") for (int m = 0; m < 4; ++m) _Pragma("unroll") for (int n = 0; n < 2; ++n) { \
        if constexpr (F6) { asm volatile("v_mfma_f32_16x16x128_f8f6f4 %0, %1, %2, 0 cbsz:2 blgp:2" : "=&v"(acc[ai][bj][m][n]) : "v"(Bt[n]), "v"(At[m])); } \
        else if constexpr (F8) { asm volatile("v_mfma_f32_16x16x128_f8f6f4 %0, %1, %2, 0" : "=&v"(acc[ai][bj][m][n]) : "v"(Bt[n]), "v"(At[m])); } \
        else { acc[ai][bj][m][n] = __builtin_amdgcn_mfma_f32_16x16x32_bf16(half8<0>(Bt[n]), half8<0>(At[m]), (f32x4){0.f, 0.f, 0.f, 0.f}, 0, 0, 0); \
               acc[ai][bj][m][n] = __builtin_amdgcn_mfma_f32_16x16x32_bf16(half8<1>(Bt[n]), half8<1>(At[m]), acc[ai][bj][m][n], 0, 0, 0); } } \
        __builtin_amdgcn_s_setprio(0); } while (0)
#define PG8_MMAF(ai, bj, At, Bt) do { if (ZI && t == 0) PG8_MMA0(ai, bj, At, Bt); else PG8_MMA(ai, bj, At, Bt); } while (0)
#define PG8_INIT(u_) do { if constexpr (ZI) { _Pragma("unroll") for (int a_ = 0; a_ < 2; ++a_) _Pragma("unroll") for (int b_ = 0; b_ < 2; ++b_) _Pragma("unroll") for (int m_ = 0; m_ < 4; ++m_) _Pragma("unroll") for (int n_ = 0; n_ < 2; ++n_) \
        asm volatile("" : "=v"(acc[a_][b_][m_][n_])); } else S.init_acc(acc, u_, wr, wc, fr, fq); } while (0)
#define PG8_WAIT_V(n) asm volatile("s_waitcnt vmcnt(" #n ")" ::: "memory")
#define PG8_WAIT_L(n) asm volatile("s_waitcnt lgkmcnt(" #n ")" ::: "memory")
#define PG8_BAR __builtin_amdgcn_s_barrier()
#define PG8_SCHED __builtin_amdgcn_sched_barrier(0)
    Unit cur, nxt; int ui = 0;
    if (!S.next(0, cur)) return;
    f32x4 acc[2][2][4][2];
    PG8_INIT(cur);
    typename FragOf<F6>::type At[4], B0[2], B1[2];
    unsigned vc[2][2], vn[2][2];
    S.a_off(cur, R0, C0, R1, C1, vc);
    const char* const Ab = S.a_base();
    const char* cB = S.b_ptr(cur);
    S.pre_unit(cur, 0, wid, lane);
    PG8_STAGE(PG8_SB(0, 0), cB, voffB); PG8_STAGE(PG8_SA(0, 0), Ab, vc[0]); PG8_STAGE(PG8_SB(0, 1), cB + hstep, voffB); PG8_STAGE(PG8_SA(0, 1), Ab, vc[1]);
    if (wr == 1) PG8_BAR;
    PG8_WAIT_V(4); PG8_BAR;
    PG8_STAGE(PG8_SB(1, 0), cB + kstep, voffB); PG8_STAGE(PG8_SA(1, 0), Ab + kstep, vc[0]); PG8_STAGE(PG8_SB(1, 1), cB + hstep + kstep, voffB);
    PG8_WAIT_V(6); PG8_BAR;
    for (;;) {
        const bool has_next = S.next(ui + 1, nxt);
        const char* nB = cB;
        if (has_next) { S.a_off(nxt, R0, C0, R1, C1, vn); nB = S.b_ptr(nxt); }
        else {
#pragma unroll
            for (int h = 0; h < 2; ++h)
#pragma unroll
                for (int i = 0; i < 2; ++i) vn[h][i] = vc[h][i]; }
#pragma unroll 1
        for (int t = 0; t < nt; t += 2) {
            const bool last = (t == nt - 2);
            const char* a1 = Ab + (size_t)(t + 1) * kstep;
            const char* a2 = last ? Ab : Ab + (size_t)(t + 2) * kstep; const char* b2 = last ? nB : cB + (size_t)(t + 2) * kstep;
            const char* a3 = a2 + kstep; const char* b3 = b2 + kstep;
            unsigned vs[2][2];
#pragma unroll
            for (int h = 0; h < 2; ++h)
#pragma unroll
                for (int i = 0; i < 2; ++i) vs[h][i] = last ? vn[h][i] : vc[h][i];
            PG8_LDB(B0, 0, 0); PG8_SCHED; PG8_LDA(At, 0, 0); PG8_STAGE(PG8_SA(1, 1), a1, vc[1]);
            PG8_WAIT_L(8); PG8_BAR; PG8_WAIT_L(0); PG8_MMAF(0, 0, At, B0); PG8_BAR; PG8_SCHED;
            PG8_LDB(B1, 0, 1); PG8_STAGE(PG8_SB(0, 0), b2, voffB);
            PG8_BAR; PG8_WAIT_L(0); PG8_MMAF(0, 1, At, B1); PG8_BAR;
            PG8_LDA(At, 0, 1); PG8_STAGE(PG8_SA(0, 0), a2, vs[0]);
            PG8_BAR; PG8_WAIT_L(0); PG8_MMAF(1, 0, At, B0); PG8_BAR; PG8_SCHED;
            PG8_STAGE(PG8_SB(0, 1), b2 + hstep, voffB);
            PG8_WAIT_V(6); PG8_BAR; PG8_MMAF(1, 1, At, B1); PG8_BAR;
            PG8_LDB(B0, 1, 0); PG8_SCHED; PG8_LDA(At, 1, 0); PG8_STAGE(PG8_SA(0, 1), a2, vs[1]);
            PG8_WAIT_L(8); PG8_BAR; PG8_WAIT_L(0); PG8_MMA(0, 0, At, B0); PG8_BAR; PG8_SCHED;
            PG8_LDB(B1, 1, 1); PG8_STAGE(PG8_SB(1, 0), b3, voffB);
            PG8_BAR; PG8_WAIT_L(0); PG8_MMA(0, 1, At, B1); PG8_BAR;
            PG8_LDA(At, 1, 1); PG8_STAGE(PG8_SA(1, 0), a3, vs[0]);
            PG8_BAR; PG8_WAIT_L(0); PG8_MMA(1, 0, At, B0); PG8_BAR; PG8_SCHED;
            PG8_STAGE(PG8_SB(1, 1), b3 + hstep, voffB);
            PG8_WAIT_V(6); PG8_BAR; PG8_MMA(1, 1, At, B1); PG8_BAR;
        }
        if constexpr (F8) asm volatile("s_nop 15\n\ts_nop 15" ::: "memory");
        if constexpr (!NOEPI) S.epi(acc, cur, wr, wc, fr, fq, ui & 1);
        else {
#pragma unroll
            for (int a = 0; a < 2; ++a)
#pragma unroll
                for (int b = 0; b < 2; ++b)
#pragma unroll
                    for (int m = 0; m < 4; ++m)
#pragma unroll
                        for (int n = 0; n < 2; ++n) asm volatile("" :: "v"(acc[a][b][m][n]));
        }
        if (!has_next) break;
        PG8_INIT(nxt);
        cur = nxt; cB = nB; ++ui;
        S.pre_unit(cur, ui & 1, wid, lane);
#pragma unroll
        for (int h = 0; h < 2; ++h)
#pragma unroll
            for (int i = 0; i < 2; ++i) vc[h][i] = vn[h][i];
    }
    PG8_WAIT_V(0);
    if (wr == 0) PG8_BAR;
    PG8_BAR;
#undef PG8_SA
#undef PG8_SB
#undef PG8_STAGE
#undef PG8_LDA
#undef PG8_LDB
#undef PG8_MMA
#undef PG8_MMA0
#undef PG8_MMAF
#undef PG8_INIT
#undef PG8_WAIT_V
#undef PG8_WAIT_L
#undef PG8_BAR
#undef PG8_SCHED
}
}

struct Frame {
    LAS unsigned char* lds;
    int tid, lane, wave, G, vcu;
    const float *x, *norm_mix_g, *w_in, *w_out, *norm_ffn_g, *w_router, *b_router, *w_gu, *b_gu, *w_dn, *b_dn, *norm_final_g;
    float* out; unsigned char* ws; unsigned* ctl;
};
struct Args { const float* in[12]; float* out; unsigned char* ws; int ph_lo, ph_hi; };

__device__ __forceinline__ void zero_acc(f32x4 (&acc)[2][2][4][2]) {
#pragma unroll
    for (int a = 0; a < 2; ++a)
#pragma unroll
        for (int b = 0; b < 2; ++b)
#pragma unroll
            for (int m = 0; m < 4; ++m)
#pragma unroll
                for (int n = 0; n < 2; ++n) acc[a][b][m][n] = (f32x4){0.f, 0.f, 0.f, 0.f};
}
template <int PB = 2048>
__device__ __forceinline__ void dense_a_off(int row0, int R0, int C0, int R1, int C1, unsigned (&vo)[2][2]) {
#pragma unroll
    for (int h = 0; h < 2; ++h) { vo[h][0] = (unsigned)((row0 + 128 * h + R0) * PB + C0 * 2); vo[h][1] = (unsigned)((row0 + 128 * h + R1) * PB + C1 * 2); }
}

struct Cx8 { f32x4 c0, c1, s0, s1; };
__device__ __forceinline__ Cx8 cx8_lds(const LAS unsigned* p) {
    const u32x4 t0 = *(const LAS u32x4*)p, t1 = *(const LAS u32x4*)(p + 4); Cx8 r;
#pragma unroll
    for (int j = 0; j < 4; ++j) { r.c0[j] = h2f_lo(t0[j]); r.s0[j] = h2f_hi(t0[j]); r.c1[j] = h2f_lo(t1[j]); r.s1[j] = h2f_hi(t1[j]); }
    return r;
}
__device__ __forceinline__ Cx8 cx8_mul(const Cx8& a, const Cx8& b) {
    Cx8 r; r.c0 = a.c0 * b.c0 - a.s0 * b.s0; r.s0 = a.c0 * b.s0 + a.s0 * b.c0; r.c1 = a.c1 * b.c1 - a.s1 * b.s1; r.s1 = a.c1 * b.s1 + a.s1 * b.c1; return r;
}
struct ProjProb {
    struct U { int pm, pn; };
    static constexpr bool PERM = true, FP8 = false, FP6 = false, ZINIT = true;
    pg8::StaticOrder so; const char* A; const char* Bt; bf16_t* dst; const unsigned* rt; const LAS unsigned char* misc; int i0 = 0, i1 = 1 << 30;
    __device__ __forceinline__ bool next(int i, U& u) const { i += i0; if (i >= i1) return false; return so.next(i, u.pm, u.pn); }
    __device__ __forceinline__ void a_off(const U& u, int R0, int C0, int R1, int C1, unsigned (&vo)[2][2]) const { dense_a_off(u.pm * 256, R0, C0, R1, C1, vo); }
    __device__ __forceinline__ const char* a_base() const { return A; }
    __device__ __forceinline__ const char* b_ptr(const U& u) const { return Bt + (size_t)u.pn * (256 * 1024 * 2); }
    __device__ __forceinline__ void init_acc(f32x4 (&acc)[2][2][4][2], const U&, int, int, int, int) const { zero_acc(acc); }
    __device__ __forceinline__ void pre_unit(const U& u, int par, int wid, int lane) const {
        __builtin_amdgcn_global_load_lds(rt + (size_t)((u.pm * 256) & 8191) * 64 + lane, (LAS unsigned*)((LAS unsigned char*)misc + MO_EPI + par * 2048 + wid * 256), 4, 0, 0);
    }
    __device__ __forceinline__ void epi(const f32x4 (&acc)[2][2][4][2], const U& u, int wr, int wc, int fr, int fq, int par) const {
        const int kind = u.pn >> 1, hp = (u.pn & 1) * 2;
        bf16_t* base = dst + (size_t)kind * ((size_t)T * 512);
        const bool rot = (kind == 0) || (kind == 1) || (kind == 4) || (kind == 5);
        const float scale = (kind == 1 || kind == 4) ? 0.08838834764831845f : 1.0f;
        if (rot) {
            const int i0 = (wc & 1) * 32 + 8 * fq, h = hp + (wc >> 1);
            const LAS unsigned* TA = (const LAS unsigned*)(misc + MO_G2); const LAS unsigned* TB = (const LAS unsigned*)(misc + MO_ROPEB);
            const LAS unsigned* EP = (const LAS unsigned*)(misc + MO_EPI + par * 2048 + (wr * 4 + wc) * 256);
            Cx8 E0 = cx8_mul(cx8_mul(cx8_lds(EP + i0), cx8_lds(TB + (4 * wr) * 64 + i0)), cx8_lds(TA + fr * 64 + i0));
            E0.c0 *= scale; E0.c1 *= scale; E0.s0 *= scale; E0.s1 *= scale;
#pragma unroll
            for (int ai = 0; ai < 2; ++ai)
#pragma unroll
                for (int m = 0; m < 4; ++m) {
                    const int row = u.pm * 256 + ai * 128 + wr * 64 + m * 16 + fr, b = row >> 13, s = row & 8191;
                    const Cx8 E = cx8_mul(E0, cx8_lds(TB + (ai * 8 + m) * 64 + i0));
                    const f32x4 c0 = E.c0, c1 = E.c1, s0 = E.s0, s1 = E.s1;
                    const f32x4 a0 = acc[ai][0][m][0], a1 = acc[ai][0][m][1], b0 = acc[ai][1][m][0], b1 = acc[ai][1][m][1];
                    const f32x4 o10 = a0 * c0 - b0 * s0, o11 = a1 * c1 - b1 * s1;
                    const f32x4 o20 = a0 * s0 + b0 * c0, o21 = a1 * s1 + b1 * c1;
                    bf16_t* p = base + ((size_t)((b * 4 + h) * 8192 + s)) * 128 + i0;
                    u32x4 w1 = {cvt_pk_bf16(o10[0], o10[1]), cvt_pk_bf16(o10[2], o10[3]), cvt_pk_bf16(o11[0], o11[1]), cvt_pk_bf16(o11[2], o11[3])};
                    u32x4 w2 = {cvt_pk_bf16(o20[0], o20[1]), cvt_pk_bf16(o20[2], o20[3]), cvt_pk_bf16(o21[0], o21[1]), cvt_pk_bf16(o21[2], o21[3])};
                    *(u32x4*)p = w1; *(u32x4*)(p + 64) = w2;
                }
        } else {
            const int col = wc * 32 + 8 * fq;
#pragma unroll
            for (int ai = 0; ai < 2; ++ai)
#pragma unroll
                for (int m = 0; m < 4; ++m) {
                    const int row = u.pm * 256 + ai * 128 + wr * 64 + m * 16 + fr, b = row >> 13, s = row & 8191;
#pragma unroll
                    for (int bj = 0; bj < 2; ++bj) {
                        f32x4 v0 = acc[ai][bj][m][0], v1 = acc[ai][bj][m][1];
                        if (kind == 3) {
#pragma unroll
                            for (int j = 0; j < 4; ++j) { v0[j] = v0[j] * __builtin_amdgcn_rcpf(1.0f + __expf(-v0[j])); v1[j] = v1[j] * __builtin_amdgcn_rcpf(1.0f + __expf(-v1[j])); }
                        }
                        u32x4 w = {cvt_pk_bf16(v0[0], v0[1]), cvt_pk_bf16(v0[2], v0[3]), cvt_pk_bf16(v1[0], v1[1]), cvt_pk_bf16(v1[2], v1[3])};
                        *(u32x4*)(base + ((size_t)((b * 4 + hp + bj) * 8192 + s)) * 128 + col) = w;
                    }
                }
        }
    }
};

struct OutProb {
    struct U { int pm, pn; };
    static constexpr bool PERM = true, FP8 = false, FP6 = false, ZINIT = false;
    pg8::StaticOrder so; const char* A; const char* Bt; const float* x; bf16_t* x1;
    __device__ __forceinline__ bool next(int i, U& u) const { return so.next(i, u.pm, u.pn); }
    __device__ __forceinline__ void a_off(const U& u, int R0, int C0, int R1, int C1, unsigned (&vo)[2][2]) const { dense_a_off(u.pm * 256, R0, C0, R1, C1, vo); }
    __device__ __forceinline__ const char* a_base() const { return A; }
    __device__ __forceinline__ const char* b_ptr(const U& u) const { return Bt + (size_t)u.pn * (256 * 1024 * 2); }
    __device__ __forceinline__ void init_acc(f32x4 (&acc)[2][2][4][2], const U& u, int wr, int wc, int fr, int fq) const {
        const int row0 = u.pm * 256 + wr * 64 + fr, col0 = u.pn * 256 + wc * 32 + 8 * fq;
#pragma unroll
        for (int ai = 0; ai < 2; ++ai)
#pragma unroll
            for (int m = 0; m < 4; ++m) {
                const size_t off = (size_t)(row0 + ai * 128 + m * 16) * 1024 + col0;
#pragma unroll
                for (int bj = 0; bj < 2; ++bj)
#pragma unroll
                    for (int n = 0; n < 2; ++n) acc[ai][bj][m][n] = __builtin_nontemporal_load((const f32x4*)(x + off + bj * 128 + n * 4));
            }
    }
    __device__ __forceinline__ void pre_unit(const U&, int, int, int) const {}
    __device__ __forceinline__ void epi(const f32x4 (&acc)[2][2][4][2], const U& u, int wr, int wc, int fr, int fq, int) const {
        const int row0 = u.pm * 256 + wr * 64 + fr, col0 = u.pn * 256 + wc * 32 + 8 * fq;
#pragma unroll
        for (int ai = 0; ai < 2; ++ai)
#pragma unroll
            for (int m = 0; m < 4; ++m) {
                const size_t off = (size_t)(row0 + ai * 128 + m * 16) * 1024 + col0;
#pragma unroll
                for (int bj = 0; bj < 2; ++bj) { const f32x4 v0 = acc[ai][bj][m][0], v1 = acc[ai][bj][m][1];
                    u32x4 w = {cvt_pk_bf16(v0[0], v0[1]), cvt_pk_bf16(v0[2], v0[3]), cvt_pk_bf16(v1[0], v1[1]), cvt_pk_bf16(v1[2], v1[3])};
                    *(u32x4*)(x1 + off + bj * 128) = w; }
            }
    }
};

struct MoeU { int mt, pn, e, ml, cnt; };
template <int NNT>
__device__ __forceinline__ bool moe_next(const LAS unsigned char* misc, int i, int G, int vcu, MoeU& u) {
    const LAS int* tp = (const LAS int*)(misc + MO_TP);
    const int TM = tp[32], total = TM * NNT;
    const int L = i * G + vcu; if (L >= total) return false;
    const int full = TM / 8, grp = L / (8 * NNT);
    int mt, pn;
    if (grp < full) { mt = grp * 8 + (L % 8); pn = (L / 8) % NNT; }
    else { const int rem = L - full * 8 * NNT, gsz = TM - full * 8; mt = full * 8 + rem % gsz; pn = rem / gsz; }
    const int e = ((const LAS unsigned char*)(misc + MO_TE))[mt];
    u.mt = __builtin_amdgcn_readfirstlane(mt); u.pn = __builtin_amdgcn_readfirstlane(pn); u.e = __builtin_amdgcn_readfirstlane(e);
    u.ml = u.mt - __builtin_amdgcn_readfirstlane(tp[e]); u.cnt = __builtin_amdgcn_readfirstlane(((const LAS int*)(misc + MO_CNT))[e]);
    return true;
}
__device__ __forceinline__ void moe_tables(Frame& F) {
    LAS unsigned char* misc = F.lds + MISC_OFF;
    LAS int* cnt = (LAS int*)(misc + MO_CNT); LAS int* tp = (LAS int*)(misc + MO_TP); LAS unsigned char* te = (LAS unsigned char*)(misc + MO_TE);
    __syncthreads();
    if (F.tid < 32) cnt[F.tid] = (int)__hip_atomic_load(F.ctl + CW_CNT + 64 * F.tid, __ATOMIC_RELAXED, __HIP_MEMORY_SCOPE_AGENT);
    __syncthreads();
    if (F.tid == 0) { int s = 0; for (int e = 0; e < 32; ++e) { tp[e] = s; s += (cnt[e] + 255) >> 8; } tp[32] = s; }
    __syncthreads();
    if (F.tid < 32) { const int a = tp[F.tid], b = tp[F.tid + 1]; for (int t = a; t < b; ++t) te[t] = (unsigned char)F.tid; }
    __syncthreads();
}
struct GuProb {
    typedef MoeU U;
    static constexpr bool PERM = true, FP8 = true, FP6 = true, ZINIT = true;
    const LAS unsigned char* misc; int G, vcu;
    const char* A; const char* Bt; const int* rtok; const float* rrstd; const float* bias; unsigned char* act;
    __device__ __forceinline__ bool next(int i, U& u) const { return moe_next<8>(misc, i, G, vcu, u); }
    __device__ __forceinline__ void a_off(const U& u, int R0, int C0, int R1, int C1, unsigned (&vo)[2][2]) const {
        const int* rt = rtok + (size_t)u.e * T; const int rb = u.ml * 256, last = u.cnt - 1;
#pragma unroll
        for (int h = 0; h < 2; ++h) {
            const int r0 = min(rb + 128 * h + R0, last), r1 = min(rb + 128 * h + R1, last);
            const int t0 = rt[r0], t1 = rt[r1];
            vo[h][0] = (unsigned)(t0 * 1024 + C0 * 2); vo[h][1] = (unsigned)(t1 * 1024 + C1 * 2);
        }
    }
    __device__ __forceinline__ const char* a_base() const { return A; }
    __device__ __forceinline__ const char* b_ptr(const U& u) const { return Bt + ((size_t)u.e * 2048 + (size_t)u.pn * 256) * 1024; }
    __device__ __forceinline__ void init_acc(f32x4 (&acc)[2][2][4][2], const U&, int, int, int, int) const { zero_acc(acc); }
    __device__ __forceinline__ void pre_unit(const U& u, int par, int wid, int lane) const {
        const int idx = wid * 64 + lane;
        const float* src = (idx < 256) ? bias + (size_t)u.e * 2048 + (idx >> 7) * 1024 + u.pn * 128 + (idx & 127)
                                       : rrstd + (size_t)u.e * T + min(u.ml * 256 + (idx - 256), u.cnt - 1);
        __builtin_amdgcn_global_load_lds((const unsigned*)src, (LAS unsigned*)((LAS unsigned char*)misc + MO_EPI + par * 2048 + wid * 256), 4, 0, 0);
    }
    __device__ __forceinline__ void epi(const f32x4 (&acc)[2][2][4][2], const U& u, int wr, int wc, int fr, int fq, int par) const {
        const int cl = wc * 32 + 8 * fq;
        const LAS float* ev = (const LAS float*)(misc + MO_EPI + par * 2048);
        const f32x4 bg0 = *(const LAS f32x4*)(ev + cl), bg1 = *(const LAS f32x4*)(ev + cl + 4), bl0 = (*(const LAS f32x4*)(ev + 128 + cl) + 1.0f) * ACT8_SCALE, bl1 = (*(const LAS f32x4*)(ev + 128 + cl + 4) + 1.0f) * ACT8_SCALE;
        float rsv[2][4];
#pragma unroll
        for (int ai = 0; ai < 2; ++ai)
#pragma unroll
            for (int m = 0; m < 4; ++m) rsv[ai][m] = ev[256 + ai * 128 + wr * 64 + m * 16 + fr];
        asm volatile("" ::: "memory");
#pragma unroll
        for (int ai = 0; ai < 2; ++ai)
#pragma unroll
            for (int m = 0; m < 4; ++m) {
                const int r = ai * 128 + wr * 64 + m * 16 + fr;
                const float rstd = rsv[ai][m] * (1.0f / (W6_SCALE * H6_SCALE));
                const f32x2 rs2 = {rstd, rstd}, rsS2 = {rstd * ACT8_SCALE, rstd * ACT8_SCALE};
                int wq[2] = {0, 0};
#pragma unroll
                for (int hq = 0; hq < 4; ++hq) {
                    const int n = hq >> 1, p = 2 * (hq & 1);
                    const f32x4 av = acc[ai][0][m][n], bvv = acc[ai][1][m][n], bgv = n ? bg1 : bg0, blv = n ? bl1 : bl0;
                    const f32x2 a2 = {av[p], av[p + 1]}, b2 = {bvv[p], bvv[p + 1]}, bg2 = {bgv[p], bgv[p + 1]}, bl2 = {blv[p], blv[p + 1]};
                    f32x2 g2 = __builtin_elementwise_fma(a2, rs2, bg2), u2 = __builtin_elementwise_fma(b2, rsS2, bl2);
                    g2 = __builtin_elementwise_min(g2, (f32x2){7.0f, 7.0f});
                    u2 = __builtin_elementwise_min(__builtin_elementwise_max(u2, (f32x2){-6.0f * ACT8_SCALE, -6.0f * ACT8_SCALE}), (f32x2){8.0f * ACT8_SCALE, 8.0f * ACT8_SCALE});
                    const f32x2 t2 = g2 * (f32x2){-2.4554669595930157f, -2.4554669595930157f};
                    f32x2 e2 = {__builtin_amdgcn_exp2f(t2[0]), __builtin_amdgcn_exp2f(t2[1])};
                    e2 = e2 + (f32x2){1.0f, 1.0f};
                    const f32x2 r2 = {__builtin_amdgcn_rcpf(e2[0]), __builtin_amdgcn_rcpf(e2[1])};
                    const f32x2 o2 = (g2 * r2) * u2;
                    wq[hq >> 1] = (hq & 1) ? __builtin_amdgcn_cvt_pk_fp8_f32(o2[0], o2[1], wq[hq >> 1], true) : __builtin_amdgcn_cvt_pk_fp8_f32(o2[0], o2[1], wq[hq >> 1], false);
                }
                u32x2 w = {(unsigned)wq[0], (unsigned)wq[1]};
                *(u32x2*)(act + (size_t)(u.mt * 256 + r) * 1024 + u.pn * 128 + cl) = w;
            }
    }
};
struct DnProb {
    typedef MoeU U;
    static constexpr bool PERM = true, FP8 = true, FP6 = false, ZINIT = true;
    const LAS unsigned char* misc; int G, vcu;
    const char* A; const char* Bt; const float* rgate; const float* bias; unsigned char* yb;
    __device__ __forceinline__ bool next(int i, U& u) const { return moe_next<4>(misc, i, G, vcu, u); }
    __device__ __forceinline__ void a_off(const U& u, int R0, int C0, int R1, int C1, unsigned (&vo)[2][2]) const { dense_a_off<1024>(u.mt * 256, R0, C0, R1, C1, vo); }
    __device__ __forceinline__ const char* a_base() const { return A; }
    __device__ __forceinline__ const char* b_ptr(const U& u) const { return Bt + ((size_t)u.e * 1024 + (size_t)u.pn * 256) * 1024; }
    __device__ __forceinline__ void init_acc(f32x4 (&acc)[2][2][4][2], const U&, int, int, int, int) const { zero_acc(acc); }
    __device__ __forceinline__ void pre_unit(const U& u, int par, int wid, int lane) const {
        const int idx = wid * 64 + lane;
        const float* src = (idx < 256) ? bias + (size_t)u.e * 1024 + u.pn * 256 + idx : rgate + (size_t)u.e * T + min(u.ml * 256 + (idx - 256), u.cnt - 1);
        __builtin_amdgcn_global_load_lds((const unsigned*)src, (LAS unsigned*)((LAS unsigned char*)misc + MO_EPI + par * 2048 + wid * 256), 4, 0, 0);
    }
    __device__ __forceinline__ void epi(const f32x4 (&acc)[2][2][4][2], const U& u, int wr, int wc, int fr, int fq, int par) const {
        const int cb = wc * 64 + fq * 16;
        const LAS float* ev = (const LAS float*)(misc + MO_EPI + par * 2048);
        f32x4 bv[2][2];
#pragma unroll
        for (int bj = 0; bj < 2; ++bj) { bv[bj][0] = *(const LAS f32x4*)(ev + cb + bj * 8); bv[bj][1] = *(const LAS f32x4*)(ev + cb + bj * 8 + 4); }
        float gtv[2][4];
#pragma unroll
        for (int ai = 0; ai < 2; ++ai)
#pragma unroll
            for (int m = 0; m < 4; ++m) gtv[ai][m] = ev[256 + ai * 128 + wr * 64 + m * 16 + fr];
        asm volatile("" ::: "memory");
#pragma unroll
        for (int ai = 0; ai < 2; ++ai)
#pragma unroll
            for (int m = 0; m < 4; ++m) {
                const int r = ai * 128 + wr * 64 + m * 16 + fr;
                const float gate = gtv[ai][m] * YB8_SCALE;
                u32x4 w;
#pragma unroll
                for (int bj = 0; bj < 2; ++bj) {
                    const f32x4 v0 = (acc[ai][bj][m][0] * (1.0f / (W8_SCALE * ACT8_SCALE)) + bv[bj][0]) * gate, v1 = (acc[ai][bj][m][1] * (1.0f / (W8_SCALE * ACT8_SCALE)) + bv[bj][1]) * gate;
                    w[2 * bj] = pk4_fp8(clamp448(v0[0]), clamp448(v0[1]), clamp448(v0[2]), clamp448(v0[3])); w[2 * bj + 1] = pk4_fp8(clamp448(v1[0]), clamp448(v1[1]), clamp448(v1[2]), clamp448(v1[3]));
                }
                *(u32x4*)(yb + (size_t)(u.mt * 256 + r) * 1024 + u.pn * 256 + cb) = w;
            }
    }
};

__device__ __forceinline__ void tr_item(const float* __restrict__ src, int ldn, int k0, int n0, bf16_t* dst, int drow0, LAS unsigned char* scr, int lane) {
    const int l15 = lane & 15, g = lane >> 4;
    f32x4 v[16];
#pragma unroll
    for (int i = 0; i < 16; ++i) { const int k = 8 * (i >> 1) + 2 * g + (i & 1); v[i] = __builtin_nontemporal_load((const f32x4*)(src + (size_t)(k0 + k) * ldn + n0 + 4 * l15)); }
#pragma unroll
    for (int j = 0; j < 8; ++j)
#pragma unroll
        for (int c = 0; c < 4; ++c) {
            const unsigned w = cvt_pk_bf16(v[2 * j][c], v[2 * j + 1][c]);
            const int n = 4 * l15 + c;
            *(LAS unsigned*)(scr + n * 128 + ((j ^ (l15 & 7)) << 4) + g * 4) = w;
        }
    LDS_WAIT();
#pragma unroll
    for (int i = 0; i < 8; ++i) {
        const int n = (lane >> 3) + 8 * i, ch = lane & 7;
        const u32x4 o = *(const LAS u32x4*)(scr + n * 128 + ((ch ^ ((n >> 2) & 7)) << 4));
        *(u32x4*)(dst + (size_t)(drow0 + n) * 1024 + k0 + 8 * ch) = o;
    }
    LDS_WAIT();
}
struct Item8 { const float* src; unsigned char* dst; int ldn; int perm; };
__device__ __forceinline__ Item8 item8_decode(Frame& F, int r) {
    Item8 it;
    if (r < 32 * 8 * 64) { const int e = r / 512, q = r % 512, kb = q / 64, nb = q % 64, n0 = nb * 32, bj = n0 >> 10, j = (n0 & 1023) >> 7, c = n0 & 127;
        it.src = F.w_gu + (size_t)e * 1024 * 2048 + (size_t)(kb * 128) * 2048 + n0; it.ldn = 2048;
        it.dst = F.ws + WS_WGU + ((size_t)e * 2048 + 256 * j + bj * 128 + c) * 1024 + kb * 128; it.perm = 0; }
    else { r -= 32 * 8 * 64; const int e = r / 256, q = r % 256, kb = q / 32, nb = q % 32;
        it.src = F.w_dn + (size_t)e * 1024 * 1024 + (size_t)(kb * 128) * 1024 + nb * 32; it.ldn = 1024;
        const int c0 = nb * 32, pn = c0 >> 8, cc = c0 & 255, wc = cc >> 6, fqh = (cc >> 5) & 1;
        it.dst = F.ws + WS_WDN + ((size_t)e * 1024 + pn * 256 + wc * 32 + fqh * 16) * 1024 + kb * 128; it.perm = 1; }
    return it;
}
__device__ __forceinline__ void item8_load(const Item8& it, f32x4 (&v)[16], int lane) {
    const int l7 = lane & 7, G = lane >> 3;
#pragma unroll
    for (int i = 0; i < 16; ++i) { const int k = 32 * (i >> 2) + 4 * G + (i & 3); v[i] = __builtin_nontemporal_load((const f32x4*)(it.src + (size_t)k * it.ldn + 4 * l7)); }
}
__device__ __forceinline__ void item8_finish(const Item8& it, const f32x4 (&v)[16], LAS unsigned char* scr, int lane) {
    const int l7 = lane & 7, G = lane >> 3;
#pragma unroll
    for (int a = 0; a < 4; ++a)
#pragma unroll
        for (int c = 0; c < 4; ++c) {
            const unsigned w = pk4_fp8(v[4 * a][c] * W8_SCALE, v[4 * a + 1][c] * W8_SCALE, v[4 * a + 2][c] * W8_SCALE, v[4 * a + 3][c] * W8_SCALE);
            *(LAS unsigned*)(scr + (4 * l7 + c) * 128 + (((8 * a + G) ^ (4 * l7)) << 2)) = w;
        }
    LDS_WAIT();
#pragma unroll
    for (int i = 0; i < 4; ++i) {
        const int n = (lane >> 3) + 8 * i, q = lane & 7;
        const u32x4 o = *(const LAS u32x4*)(scr + n * 128 + ((q ^ (n >> 2)) << 4));
        const int dr = it.perm ? (((n >> 4) & 1) * 8 + ((n >> 3) & 1) * 128 + (n & 7)) : n;
        __builtin_nontemporal_store(o, (u32x4*)(it.dst + (size_t)dr * 1024 + 16 * q));
    }
    LDS_WAIT();
}
constexpr int I8_TOTAL = 32 * 8 * 64 + 32 * 8 * 32;
struct Item6 { const float* src; unsigned char* dst; };
__device__ __forceinline__ Item6 item6_decode(Frame& F, int r) {
    Item6 it; const int e = r >> 8, q = r & 255, kb = q >> 5, n0 = (q & 31) * 64, bj = n0 >> 10, j = (n0 & 1023) >> 7, c = n0 & 127;
    it.src = F.w_gu + (size_t)e * 1024 * 2048 + (size_t)(kb * 128) * 2048 + n0;
    it.dst = F.ws + WS_WGU + ((size_t)e * 2048 + 256 * j + bj * 128 + c) * 1024 + kb * 128;
    return it;
}
__device__ __forceinline__ void item6_load(const Item6& it, int H, f32x16 (&v)[4], int lane) {
#pragma unroll
    for (int q = 0; q < 4; ++q)
#pragma unroll
        for (int j = 0; j < 16; ++j) { const int k = (q >> 1) * 64 + 32 * H + (q & 1) * 16 + j; v[q][j] = __builtin_nontemporal_load(it.src + (size_t)k * 2048 + lane); }
}
__device__ __forceinline__ void item6_finish(int H, const f32x16 (&v)[4], LAS unsigned char* scr, int lane) {
#pragma unroll
    for (int gg = 0; gg < 2; ++gg) {
        f32x16 a, b;
#pragma unroll
        for (int j = 0; j < 16; ++j) { a[j] = __builtin_amdgcn_fmed3f(v[gg][j] * W6_SCALE, -7.5f, 7.5f); b[j] = __builtin_amdgcn_fmed3f(v[2 + gg][j] * W6_SCALE, -7.5f, 7.5f); }
        const u32x6 q6 = __builtin_amdgcn_cvt_scalef32_2xpk16_fp6_f32(a, b, 1.0f);
        const int g = 2 * H + gg;
        *(LAS u32x4*)(scr + lane * 128 + ((g ^ (lane & 7)) << 4)) = (u32x4){q6[0], q6[1], q6[2], q6[3]};
        *(LAS u32x4*)(scr + lane * 128 + (((4 + g) ^ (lane & 7)) << 4)) = (u32x4){q6[4], q6[5], 0u, 0u};
    }
}
__device__ __forceinline__ void item6_flush(const Item6& it, LAS unsigned char* scr, int lane) {
    LDS_WAIT();
#pragma unroll
    for (int i = 0; i < 8; ++i) {
        const int n = (lane >> 3) + 8 * i, q = lane & 7;
        const u32x4 o = *(const LAS u32x4*)(scr + n * 128 + ((q ^ (n & 7)) << 4));
        __builtin_nontemporal_store(o, (u32x4*)(it.dst + (size_t)n * 1024 + 16 * q));
    }
    LDS_WAIT();
}
constexpr int I6_TOTAL = 32 * 8 * 32;
template <bool ONCE = false>
__device__ __forceinline__ void conv_loop(Frame& F) {
    int lane = F.lane; asm volatile("" : "+v"(lane));
    {
        f32x16 va[4], vb[4];
        LAS unsigned char* scr6 = F.lds + F.wave * 8192;
        for (;;) {
            int base = 0;
            if (lane == 0) base = (int)atomicAdd(F.ctl + CW_CONV6, 2u);
            base = __builtin_amdgcn_readfirstlane(base);
            if (base >= I6_TOTAL) break;
            const Item6 i0 = item6_decode(F, base), i1 = item6_decode(F, base + 1);
            item6_load(i0, 0, va, lane); item6_load(i0, 1, vb, lane);
            item6_finish(0, va, scr6, lane); item6_load(i1, 0, va, lane);
            item6_finish(1, vb, scr6, lane); item6_load(i1, 1, vb, lane); item6_flush(i0, scr6, lane);
            item6_finish(0, va, scr6, lane);
            item6_finish(1, vb, scr6, lane); item6_flush(i1, scr6, lane);
            if (ONCE) return;
        }
    }
    LAS unsigned char* scr = F.lds + F.wave * 8192;
    f32x4 va[16], vb[16];
    for (;;) {
        int base = 0;
        if (lane == 0) base = (int)atomicAdd(F.ctl + CW_CONV, 8u);
        base = __builtin_amdgcn_readfirstlane(base) + 32 * 8 * 64;
        if (base >= I8_TOTAL) break;
        Item8 i0 = item8_decode(F, base), i1 = item8_decode(F, base + 1);
        item8_load(i0, va, lane); item8_load(i1, vb, lane);
#pragma unroll
        for (int k = 2; k < 8; k += 2) {
            item8_finish(i0, va, scr, lane); i0 = item8_decode(F, base + k); item8_load(i0, va, lane);
            item8_finish(i1, vb, scr, lane); i1 = item8_decode(F, base + k + 1); item8_load(i1, vb, lane);
        }
        item8_finish(i0, va, scr, lane);
        item8_finish(i1, vb, scr, lane);
        if (ONCE) return;
    }
}
__device__ __forceinline__ void p0_prologue(Frame& F) {
    LAS unsigned char* scr = F.lds + F.wave * 8192;
    const int gw = F.vcu * NWAVES + F.wave, NGW = F.G * NWAVES;
    constexpr int I_IN = 16 * 56, I_OUT = 16 * 16, NITEMS = I_IN + I_OUT;
    bf16_t* wt_in = (bf16_t*)(F.ws + WS_WIN); bf16_t* wt_out = (bf16_t*)(F.ws + WS_WOUT);
    for (int it = gw; it < NITEMS; it += NGW) {
        int r = it;
        if (r < I_IN) { const int kb = r / 56, nb = r % 56, n0 = nb * 64, tile = n0 >> 8, kind = tile >> 1;
            int drow = n0;
            if (kind == 0 || kind == 1 || kind == 4 || kind == 5) { const int w = n0 & 255, hd = w >> 7, bj = (w >> 6) & 1; drow = tile * 256 + bj * 128 + hd * 64; }
            tr_item(F.w_in, DIN, kb * 64, n0, wt_in, drow, scr, F.lane); continue; }
        r -= I_IN;
        { const int kb = r / 16, nb = r % 16; tr_item(F.w_out, 1024, kb * 64, nb * 64, wt_out, nb * 64, scr, F.lane); }
    }
    {
        bf16_t* hb = (bf16_t*)(F.ws + WS_H);
        f32x4 gv[4];
#pragma unroll
        for (int j = 0; j < 4; ++j) gv[j] = *((const f32x4*)F.norm_mix_g + F.lane + 64 * j);
        for (int m0 = gw; m0 < T; m0 += 2 * NGW) {
            f32x4 v[2][4];
#pragma unroll
            for (int b = 0; b < 2; ++b) { const int m = min(m0 + b * NGW, T - 1); const f32x4* xr = (const f32x4*)(F.x + (size_t)m * DM) + F.lane;
#pragma unroll
                for (int j = 0; j < 4; ++j) v[b][j] = __builtin_nontemporal_load(xr + 64 * j); }
#pragma unroll
            for (int b = 0; b < 2; ++b) { const int m = m0 + b * NGW; if (m >= T) break;
                float ssum = 0.f;
#pragma unroll
                for (int j = 0; j < 4; ++j) ssum += (v[b][j][0] * v[b][j][0] + v[b][j][1] * v[b][j][1]) + (v[b][j][2] * v[b][j][2] + v[b][j][3] * v[b][j][3]);
                const float rstd = 1.0f / sqrtf(wave_sum(ssum) * (1.0f / DM) + NORM_EPS);
                u32x2* o = (u32x2*)(hb + (size_t)m * DM) + F.lane;
#pragma unroll
                for (int j = 0; j < 4; ++j) { const f32x4 y = v[b][j] * rstd * gv[j]; u32x2 w = {cvt_pk_bf16(y[0], y[1]), cvt_pk_bf16(y[2], y[3])}; o[64 * j] = w; } }
        }
    }
    {
        unsigned short* whi = (unsigned short*)(F.ws + WS_WR); unsigned short* wlo = whi + 32768;
        for (int q = F.vcu * NTHR + F.tid; q < 1024 * 32; q += F.G * NTHR) {
            const int k = q >> 5, e = q & 31; const float v = F.w_router[q];
            const unsigned hi = cvt_pk_bf16(v, 0.f) & 0xffffu; const float lo = v - __uint_as_float(hi << 16);
            const int off = e * 1024 + ((((k >> 3) ^ (e & 15))) << 3) + (k & 7);
            whi[off] = (unsigned short)hi; wlo[off] = (unsigned short)(cvt_pk_bf16(lo, 0.f) & 0xffffu);
        }
    }
    {
        unsigned* rt = (unsigned*)(F.ws + WS_ROPE);
        for (int idx = (F.vcu * NTHR + F.tid); idx < 8192 * 64; idx += F.G * NTHR) {
            const int pos = idx >> 6, i = idx & 63;
            const float inv = exp2f(-(float)i * (13.287712379549449f / 64.0f));
            const float ang = (float)pos * inv;
            const double xd = (double)ang; const double n = __builtin_rint(xd * 0.6366197723675814);
            double r = __builtin_fma(-n, 1.5707963267948966, xd); r = __builtin_fma(-n, 6.123233995736766e-17, r);
            const double r2 = r * r;
            const double sn = r + r * r2 * (-1.0 / 6 + r2 * (1.0 / 120 + r2 * (-1.0 / 5040 + r2 * (1.0 / 362880 + r2 * (-1.0 / 39916800)))));
            const double cs = 1.0 + r2 * (-0.5 + r2 * (1.0 / 24 + r2 * (-1.0 / 720 + r2 * (1.0 / 40320 + r2 * (-1.0 / 3628800 + r2 * (1.0 / 479001600))))));
            const int q = ((int)n) & 3;
            const double so = (q == 0) ? sn : (q == 1) ? cs : (q == 2) ? -sn : -cs;
            const double co = (q == 0) ? cs : (q == 1) ? -sn : (q == 2) ? -cs : sn;
            { union { _Float16 h[2]; unsigned u; } pk; pk.h[0] = (_Float16)(float)co; pk.h[1] = (_Float16)(float)so; rt[idx] = pk.u; }
        }
    }
}

__device__ __forceinline__ int rr_off(int r, int ch) { return r * 256 + ((ch ^ (r & 15)) << 4); }
__device__ __forceinline__ int tr_off(int r, int cb) { return r * 256 + (cb ^ ((r & 7) << 5)); }
template <int MODE>
__device__ __forceinline__ void stage_tile(LAS unsigned char* img, const bf16_t* g, size_t gstride, int nrows, int tid) {
    for (int q = tid; q < nrows * 16; q += NTHR) {
        const int r = q >> 4, ch = q & 15;
        const u32x4 v = *(const u32x4*)(g + (size_t)r * gstride + ch * 8);
        *(LAS u32x4*)(img + (MODE == 0 ? rr_off(r, ch) : tr_off(r, ch * 16))) = v;
    }
}
__device__ __forceinline__ bf16x8 rr_frag(const LAS unsigned char* img, int r0, int ks, int i, int g) {
    return *(const LAS bf16x8*)(img + (r0 + i) * 256 + (((4 * ks + g) ^ i) << 4));
}
__device__ __forceinline__ s16x4 tr_frag(const LAS unsigned char* img, int rb, int cb, int i, int g) {
    const int row = 16 * rb + 4 * g + (i >> 2), colb = 32 * cb + 8 * (i & 3);
    return __builtin_amdgcn_ds_read_tr16_b64_v4i16((LAS s16x4*)(img + row * 256 + (colb ^ (((4 * g + (i >> 2)) & 7) << 5))));
}
__device__ __forceinline__ bf16x8 cat4(s16x4 a, s16x4 b) { return (bf16x8){a[0], a[1], a[2], a[3], b[0], b[1], b[2], b[3]}; }
__device__ __forceinline__ bf16x8 pack_f8(f32x4 a, f32x4 b) { u32x4 w = {cvt_pk_bf16(a[0], a[1]), cvt_pk_bf16(a[2], a[3]), cvt_pk_bf16(b[0], b[1]), cvt_pk_bf16(b[2], b[3])}; return as_bf16x8(w); }
#define MFMA16(a, b, c) __builtin_amdgcn_mfma_f32_16x16x32_bf16(a, b, c, 0, 0, 0)

struct BlkRegs { u32x4 k[4], v[4]; };
struct AttnSeq { const bf16_t* Q; const bf16_t* K; const bf16_t* V; int br, bh, d, r, nb0, len; };
__device__ __forceinline__ AttnSeq attn_run(Frame& F, int run) {
    AttnSeq q; const int rem = run & 255; q.bh = rem >> 4; const int x = rem & 15;
    if (run < 256) { if (x < 8) { q.br = 0; q.r = 0; q.nb0 = 8 * x; } else { q.br = 1; q.r = (x - 8) >> 1; q.nb0 = 8 * ((x - 8) & 1); } q.len = 8; }
    else { q.br = 2; q.r = x; q.nb0 = 0; q.len = 4; }
    q.d = 1 << (2 * q.br);
    const bf16_t* P = (const bf16_t*)(F.ws + WS_C);
    q.Q = P + (size_t)4 * T * 512 + (size_t)q.bh * SEQ * 128; q.K = P + (size_t)5 * T * 512 + (size_t)q.bh * SEQ * 128; q.V = P + (size_t)6 * T * 512 + (size_t)q.bh * SEQ * 128;
    return q;
}
__device__ __forceinline__ void blk_issue(Frame& F, const AttnSeq& q, int blk, BlkRegs& R) {
#pragma unroll
    for (int j = 0; j < 4; ++j) {
        const int c = F.tid + NTHR * j, row = c >> 4, ch = c & 15;
        const size_t off = ((size_t)(blk * 128 + row) * q.d + q.r) * 128 + ch * 8;
        R.k[j] = *(const u32x4*)(q.K + off); R.v[j] = *(const u32x4*)(q.V + off);
    }
}
__device__ __forceinline__ void blk_write(Frame& F, int slot, const BlkRegs& R) {
    LAS unsigned char* Kl = F.lds + slot * 32768; LAS unsigned char* Vl = F.lds + 65536 + slot * 32768;
#pragma unroll
    for (int j = 0; j < 4; ++j) {
        const int c = F.tid + NTHR * j, row = c >> 4, ch = c & 15;
        *(LAS u32x4*)(Kl + rr_off(row, ch)) = R.k[j]; *(LAS u32x4*)(Vl + tr_off(row, ch * 16)) = R.v[j];
    }
}
__device__ __forceinline__ void q_issue(Frame& F, const AttnSeq& q, int nb, bf16x8 (&qf)[4]) {
    const int lq = nb * 128 + 16 * F.wave + (F.lane & 15), g = F.lane >> 4;
#pragma unroll
    for (int ks = 0; ks < 4; ++ks) qf[ks] = *(const bf16x8*)(q.Q + ((size_t)lq * q.d + q.r) * 128 + 32 * ks + 8 * g);
}
__device__ __forceinline__ void attn_compute(Frame& F, const AttnSeq& q, int nb, int sp, const bf16x8 (&qf)[4]) {
    const int lane = F.lane, w = F.wave, i = lane & 15, g = lane >> 4;
    const int lq = nb * 128 + 16 * w + i;
    const float NEG = -__builtin_inff();
    int kof[4], vof[8];
#pragma unroll
    for (int ks = 0; ks < 4; ++ks) kof[ks] = i * 256 + (((4 * ks + g) ^ i) << 4);
    { const int rl = 4 * g + (i >> 2);
#pragma unroll
      for (int eb = 0; eb < 8; ++eb) vof[eb] = 65536 + rl * 256 + ((32 * eb + 8 * (i & 3)) ^ ((rl & 7) << 5)); }
    f32x4 sc[9];
    bf16x8 kf[2][4];
#define ATT_KB(kbi_) ((((w + (kbi_)) < 8) ? sp : (sp ^ 1)) * 32768 + ((w + (kbi_)) & 7) * 4096)
#define ATT_LDK(buf, kbi_) do { const int bo_ = ATT_KB(kbi_); _Pragma("unroll") for (int ks = 0; ks < 4; ++ks) kf[buf][ks] = *(const LAS bf16x8*)(F.lds + bo_ + kof[ks]); } while (0)
    ATT_LDK(0, 0);
#pragma unroll
    for (int kbi = 0; kbi < 9; ++kbi) {
        if (kbi + 1 < 9) ATT_LDK((kbi + 1) & 1, kbi + 1);
        f32x4 c = {0.f, 0.f, 0.f, 0.f};
#pragma unroll
        for (int ks = 0; ks < 4; ++ks) c = MFMA16(kf[kbi & 1][ks], qf[ks], c);
        sc[kbi] = c;
    }
#undef ATT_LDK
#pragma unroll
    for (int rg = 0; rg < 4; ++rg) { sc[0][rg] = (i <= 4 * g + rg) ? sc[0][rg] : NEG; sc[8][rg] = (i >= 4 * g + rg) ? sc[8][rg] : NEG; }
    if (nb == 0) {
#pragma unroll
        for (int kbi = 0; kbi < 8; ++kbi) if (w + kbi < 8) sc[kbi] = (f32x4){NEG, NEG, NEG, NEG};
    }
    float mx = fmaxf(fmaxf(sc[0][0], sc[0][1]), fmaxf(sc[0][2], sc[0][3]));
#pragma unroll
    for (int kbi = 1; kbi < 9; ++kbi) mx = fmaxf(mx, fmaxf(fmaxf(sc[kbi][0], sc[kbi][1]), fmaxf(sc[kbi][2], sc[kbi][3])));
    mx = fmaxf(mx, __shfl_xor(mx, 16)); mx = fmaxf(mx, __shfl_xor(mx, 32));
    const float mxl = -mx * 1.4426950408889634f;
    float den = 0.f;
#pragma unroll
    for (int kbi = 0; kbi < 9; ++kbi)
#pragma unroll
        for (int rg = 0; rg < 4; ++rg) { const float p = __builtin_amdgcn_exp2f(__builtin_fmaf(sc[kbi][rg], 1.4426950408889634f, mxl)); sc[kbi][rg] = p; den += p; }
    den += __shfl_xor(den, 16); den += __shfl_xor(den, 32);
    f32x4 o[8];
#pragma unroll
    for (int eb = 0; eb < 8; ++eb) o[eb] = (f32x4){0.f, 0.f, 0.f, 0.f};
    s16x4 vf[2][4][2];
#define ATT_LDV(buf, hs_) do { const int t_ = (hs_) >> 1, e0_ = 4 * ((hs_) & 1); const int b0_ = ATT_KB(2 * t_), b1_ = (2 * t_ + 1 < 9 && w + 2 * t_ + 1 <= 15) ? ATT_KB(2 * t_ + 1) : b0_; \
        _Pragma("unroll") for (int e = 0; e < 4; ++e) { vf[buf][e][0] = __builtin_amdgcn_ds_read_tr16_b64_v4i16((LAS s16x4*)(F.lds + b0_ + vof[e0_ + e])); \
                                                        vf[buf][e][1] = __builtin_amdgcn_ds_read_tr16_b64_v4i16((LAS s16x4*)(F.lds + b1_ + vof[e0_ + e])); } } while (0)
    ATT_LDV(0, 0);
#pragma unroll
    for (int hs = 0; hs < 10; ++hs) {
        if (hs + 1 < 10) ATT_LDV((hs + 1) & 1, hs + 1);
        const int t = hs >> 1;
        const f32x4 z = {0.f, 0.f, 0.f, 0.f};
        const bf16x8 pf = pack_f8(sc[2 * t], (2 * t + 1 < 9) ? sc[(2 * t + 1 < 9) ? 2 * t + 1 : 8] : z);
#pragma unroll
        for (int e = 0; e < 4; ++e) o[4 * (hs & 1) + e] = MFMA16(cat4(vf[hs & 1][e][0], vf[hs & 1][e][1]), pf, o[4 * (hs & 1) + e]);
    }
#undef ATT_LDV
#undef ATT_KB
    const float rden = __builtin_amdgcn_rcpf(den);
    const int tok = (q.bh >> 2) * SEQ + lq * q.d + q.r, h = q.bh & 3;
    bf16_t* ob = (bf16_t*)(F.ws + WS_OBR) + ((size_t)q.br * T + tok) * 512 + h * 128 + 4 * g;
    u32x2 wv[8];
#pragma unroll
    for (int eb = 0; eb < 8; ++eb) { const f32x4 v = o[eb] * rden; wv[eb] = (u32x2){cvt_pk_bf16(v[0], v[1]), cvt_pk_bf16(v[2], v[3])}; }
    bf16_t* ob16 = ob + ((g & 1) ? 12 : 0);
#pragma unroll
    for (int eb = 0; eb < 8; eb += 2) {
        const u32x2 s0 = __builtin_amdgcn_permlane16_swap(wv[eb][0], wv[eb + 1][0], false, false), s1 = __builtin_amdgcn_permlane16_swap(wv[eb][1], wv[eb + 1][1], false, false);
        *(u32x4*)(ob16 + 16 * eb) = (u32x4){s0[0], s1[0], s0[1], s1[1]};
    }
    if (g == 0) ((float*)(F.ws + WS_LSE))[((size_t)q.br * T + tok) * 4 + h] = mx + __logf(den);
}
__device__ __forceinline__ void attn_all(Frame& F) {
    BlkRegs RB; bf16x8 qn[4], qf[4];
    int run = F.vcu;
    while (run < 512) {
        AttnSeq q = attn_run(F, run);
        {
            BlkRegs RA;
            if (q.nb0 > 0) blk_issue(F, q, q.nb0 - 1, RA);
            blk_issue(F, q, q.nb0, RB); q_issue(F, q, q.nb0, qn);
            __syncthreads();
            if (q.nb0 > 0) blk_write(F, 1, RA);
        }
        for (int j = 0;; ) {
            __syncthreads();
            blk_write(F, j & 1, RB);
#pragma unroll
            for (int ks = 0; ks < 4; ++ks) { qf[ks] = qn[ks]; asm volatile("" : "+v"(qf[ks])); }
            __syncthreads();
            const AttnSeq qc = q; const int nb = q.nb0 + j, sp = (j & 1) ^ 1;
            bool cont = true;
            if (j < q.len - 1) { blk_issue(F, q, nb + 1, RB); q_issue(F, q, nb + 1, qn); ++j; }
            else {
                run += F.G; cont = false;
                if (run < 512) { const AttnSeq nq = attn_run(F, run); if (nq.nb0 == 0) { q = nq; blk_issue(F, q, 0, RB); q_issue(F, q, 0, qn); j = 0; cont = true; } }
            }
            attn_compute(F, qc, nb, sp, qf);
            if (!cont) break;
        }
    }
}

__device__ __forceinline__ float ret_log2g(int h) { return log2f(1.0f - exp2f(-5.0f - (float)h)); }
__device__ __forceinline__ void kv_units(Frame& F) {
    const bf16_t* P = (const bf16_t*)(F.ws + WS_C);
    LAS unsigned char* Kl = F.lds; LAS unsigned char* Vl = F.lds + 32768;
    const int lane = F.lane, w = F.wave, i = lane & 15, g = lane >> 4;
    u32x4 kr[4], vr[4];
    int u = F.vcu;
    if (u < 1024) {
        const bf16_t* Kg = P + (size_t)1 * T * 512 + ((size_t)(u >> 6) * SEQ + (u & 63) * 128) * 128; const bf16_t* Vg = Kg + (size_t)T * 512;
#pragma unroll
        for (int j = 0; j < 4; ++j) { const int q = F.tid + NTHR * j; kr[j] = *(const u32x4*)(Kg + (size_t)q * 8); vr[j] = *(const u32x4*)(Vg + (size_t)q * 8); }
    }
    while (u < 1024) {
        const float l2g = ret_log2g((u >> 6) & 3);
        __syncthreads();
#pragma unroll
        for (int j = 0; j < 4; ++j) {
            const int q = F.tid + NTHR * j, r = q >> 4, ch = q & 15;
            const float z = exp2f((float)(127 - r) * l2g);
            u32x4 o;
#pragma unroll
            for (int c = 0; c < 4; ++c) o[c] = cvt_pk_bf16(bflo(vr[j][c]) * z, bfhi(vr[j][c]) * z);
            *(LAS u32x4*)(Vl + tr_off(r, ch * 16)) = o;
            *(LAS u32x4*)(Kl + tr_off(r, ch * 16)) = kr[j];
        }
        __syncthreads();
        const int un = u + F.G;
        if (un < 1024) {
            const bf16_t* Kg = P + (size_t)1 * T * 512 + ((size_t)(un >> 6) * SEQ + (un & 63) * 128) * 128; const bf16_t* Vg = Kg + (size_t)T * 512;
#pragma unroll
            for (int j = 0; j < 4; ++j) { const int q = F.tid + NTHR * j; kr[j] = *(const u32x4*)(Kg + (size_t)q * 8); vr[j] = *(const u32x4*)(Vg + (size_t)q * 8); }
        }
        const int eb0 = 2 * (w & 3), db0 = 4 * (w >> 2);
        f32x4 acc[2][4];
#pragma unroll
        for (int a = 0; a < 2; ++a)
#pragma unroll
            for (int b = 0; b < 4; ++b) acc[a][b] = (f32x4){0.f, 0.f, 0.f, 0.f};
#pragma unroll
        for (int t = 0; t < 4; ++t) {
            bf16x8 af[2], bf[4];
#pragma unroll
            for (int a = 0; a < 2; ++a) af[a] = cat4(tr_frag(Vl, 2 * t, eb0 + a, i, g), tr_frag(Vl, 2 * t + 1, eb0 + a, i, g));
#pragma unroll
            for (int b = 0; b < 4; ++b) bf[b] = cat4(tr_frag(Kl, 2 * t, db0 + b, i, g), tr_frag(Kl, 2 * t + 1, db0 + b, i, g));
#pragma unroll
            for (int a = 0; a < 2; ++a)
#pragma unroll
                for (int b = 0; b < 4; ++b) acc[a][b] = MFMA16(bf[b], af[a], acc[a][b]);
        }
        bf16_t* kv = (bf16_t*)(F.ws + WS_KV) + (size_t)u * 16384;
#pragma unroll
        for (int a = 0; a < 2; ++a)
#pragma unroll
            for (int b = 0; b < 4; ++b) { u32x2 wv = {cvt_pk_bf16(acc[a][b][0], acc[a][b][1]), cvt_pk_bf16(acc[a][b][2], acc[a][b][3])};
                *(u32x2*)(kv + (16 * (eb0 + a) + i) * 128 + 16 * (db0 + b) + 4 * g) = wv; }
        u = un;
    }
}

__device__ __forceinline__ void p3_scan(Frame& F) {
    const unsigned* kv = (const unsigned*)(F.ws + WS_KV); unsigned* st = (unsigned*)(F.ws + WS_ST);
    for (int q = F.vcu * NTHR + F.tid; q < 16 * 8192; q += F.G * NTHR) {
        const int bh = q >> 13, ep = q & 8191, h = bh & 3;
        const float dec = exp2f(128.0f * ret_log2g(h));
        const unsigned* src = kv + (size_t)bh * 64 * 8192 + ep; unsigned* dstp = st + (size_t)bh * 64 * 8192 + ep;
        float s0 = 0.f, s1 = 0.f;
#pragma unroll 16
        for (int n = 0; n < 64; ++n) { dstp[(size_t)n * 8192] = cvt_pk_bf16(s0, s1); const unsigned k = __builtin_nontemporal_load(src + (size_t)n * 8192); s0 = s0 * dec + bflo(k); s1 = s1 * dec + bfhi(k); }
    }
}

struct RetRegs { u32x4 tq[4], tk[4], tv[4], ts[4]; };
__device__ __forceinline__ void retout_issue(Frame& F, int u, RetRegs& R) {
    const bf16_t* P = (const bf16_t*)(F.ws + WS_C);
    const int bh = u >> 6, n = u & 63;
    const size_t hoff = ((size_t)bh * SEQ + n * 128) * 128;
    const bf16_t* sg = (const bf16_t*)(F.ws + WS_ST) + (size_t)u * 16384;
#pragma unroll
    for (int j = 0; j < 4; ++j) { const size_t q8 = (size_t)(F.tid + NTHR * j) * 8;
        R.tq[j] = __builtin_nontemporal_load((const u32x4*)(P + hoff + q8)); R.tk[j] = __builtin_nontemporal_load((const u32x4*)(P + (size_t)1 * T * 512 + hoff + q8));
        R.tv[j] = __builtin_nontemporal_load((const u32x4*)(P + (size_t)2 * T * 512 + hoff + q8)); R.ts[j] = __builtin_nontemporal_load((const u32x4*)(sg + q8)); }
}
__device__ __forceinline__ void retout_write(Frame& F, const RetRegs& R) {
    LAS unsigned char* Ql = F.lds; LAS unsigned char* Kl = F.lds + 32768; LAS unsigned char* Vl = F.lds + 65536; LAS unsigned char* Sl = F.lds + 98304;
#pragma unroll
    for (int j = 0; j < 4; ++j) { const int q = F.tid + NTHR * j, r = q >> 4, ch = q & 15;
        *(LAS u32x4*)(Ql + rr_off(r, ch)) = R.tq[j]; *(LAS u32x4*)(Kl + rr_off(r, ch)) = R.tk[j]; *(LAS u32x4*)(Vl + tr_off(r, ch * 16)) = R.tv[j]; *(LAS u32x4*)(Sl + rr_off(r, ch)) = R.ts[j]; }
}
__device__ __forceinline__ void retout_compute(Frame& F, int u) {
    const int bh = u >> 6, n = u & 63, h = bh & 3, b = bh >> 2;
    const bf16_t* P = (const bf16_t*)(F.ws + WS_C);
    const size_t hoff = ((size_t)bh * SEQ + n * 128) * 128;
    const LAS unsigned char* Ql = F.lds; const LAS unsigned char* Kl = F.lds + 32768; const LAS unsigned char* Vl = F.lds + 65536; const LAS unsigned char* Sl = F.lds + 98304;
    const int lane = F.lane, w = F.wave, i = lane & 15, g = lane >> 4;
    const float l2g = ret_log2g(h);
    bf16x8 qf[4];
#pragma unroll
    for (int ks = 0; ks < 4; ++ks) qf[ks] = rr_frag(Ql, 16 * w, ks, i, g);
    const int qi = 16 * w + i;
    f32x4 oi[8];
    { const float xi = exp2f((float)(qi + 1) * l2g);
      bf16x8 qx[4];
#pragma unroll
      for (int ks = 0; ks < 4; ++ks) { const u32x4 qw = *reinterpret_cast<const u32x4*>(&qf[ks]); u32x4 o;
#pragma unroll
          for (int c = 0; c < 4; ++c) o[c] = cvt_pk_bf16(bflo(qw[c]) * xi, bfhi(qw[c]) * xi);
          qx[ks] = as_bf16x8(o); }
#pragma unroll
      for (int eb = 0; eb < 8; ++eb) {
          f32x4 c = {0.f, 0.f, 0.f, 0.f};
#pragma unroll
          for (int ks = 0; ks < 4; ++ks) c = MFMA16(rr_frag(Sl, 16 * eb, ks, i, g), qx[ks], c);
          oi[eb] = c;
      } }
    for (int t = 0; 2 * t <= w; ++t) {
        f32x4 s0 = {0.f, 0.f, 0.f, 0.f}, s1 = {0.f, 0.f, 0.f, 0.f};
        const int jb0 = 2 * t, jb1 = 2 * t + 1;
#pragma unroll
        for (int ks = 0; ks < 4; ++ks) s0 = MFMA16(rr_frag(Kl, 16 * jb0, ks, i, g), qf[ks], s0);
        if (jb1 <= w) {
#pragma unroll
            for (int ks = 0; ks < 4; ++ks) s1 = MFMA16(rr_frag(Kl, 16 * jb1, ks, i, g), qf[ks], s1);
        }
#pragma unroll
        for (int rg = 0; rg < 4; ++rg) {
            const int d0 = qi - (16 * jb0 + 4 * g + rg), d1 = qi - (16 * jb1 + 4 * g + rg);
            s0[rg] = d0 >= 0 ? s0[rg] * exp2f((float)d0 * l2g) : 0.f;
            s1[rg] = d1 >= 0 ? s1[rg] * exp2f((float)d1 * l2g) : 0.f;
        }
        const bf16x8 pf = pack_f8(s0, s1);
#pragma unroll
        for (int eb = 0; eb < 8; ++eb) oi[eb] = MFMA16(cat4(tr_frag(Vl, jb0, eb, i, g), tr_frag(Vl, jb1, eb, i, g)), pf, oi[eb]);
    }
    float s = 0.f;
#pragma unroll
    for (int eb = 0; eb < 8; ++eb) s += (oi[eb][0] + oi[eb][1]) + (oi[eb][2] + oi[eb][3]);
    s += __shfl_xor(s, 16); s += __shfl_xor(s, 32);
    const float mean = s * (1.0f / 128.0f);
    float q2 = 0.f;
#pragma unroll
    for (int eb = 0; eb < 8; ++eb) { oi[eb] = oi[eb] - mean; q2 += (oi[eb][0] * oi[eb][0] + oi[eb][1] * oi[eb][1]) + (oi[eb][2] * oi[eb][2] + oi[eb][3] * oi[eb][3]); }
    q2 += __shfl_xor(q2, 16); q2 += __shfl_xor(q2, 32);
    const float rstd = 1.0f / sqrtf(q2 * (1.0f / 128.0f) + NORM_EPS);
    const bf16_t* gp = P + (size_t)3 * T * 512 + hoff + (size_t)qi * 128 + 4 * g;
    bf16_t* cp = (bf16_t*)(F.ws + WS_H) + ((size_t)(b * SEQ + n * 128 + qi)) * 1024 + h * 128 + 4 * g;
#pragma unroll
    for (int eb = 0; eb < 8; ++eb) {
        const u32x2 gv = *(const u32x2*)(gp + 16 * eb);
        const f32x4 y = oi[eb] * rstd;
        u32x2 wv = {cvt_pk_bf16(y[0] * bflo(gv[0]), y[1] * bfhi(gv[0])), cvt_pk_bf16(y[2] * bflo(gv[1]), y[3] * bfhi(gv[1]))};
        *(u32x2*)(cp + 16 * eb) = wv;
    }
}
__device__ __forceinline__ void retout_all(Frame& F) {
    RetRegs R;
    int u = F.vcu;
    if (u < 1024) retout_issue(F, u, R);
    while (u < 1024) {
        __syncthreads();
        retout_write(F, R);
        __syncthreads();
        const int un = u + F.G;
        if (un < 1024) retout_issue(F, un, R);
        retout_compute(F, u);
        u = un;
    }
}
__device__ __forceinline__ void combine_tokens(Frame& F) {
    const int gw = F.vcu * NWAVES + F.wave, NGW = F.G * NWAVES, lane = F.lane, h = lane >> 4;
    const bf16_t* ob = (const bf16_t*)(F.ws + WS_OBR); const float* lse = (const float*)(F.ws + WS_LSE);
    bf16_t* cat = (bf16_t*)(F.ws + WS_H);
    constexpr int NB = 4;
    for (int t0 = gw; t0 < T; t0 += NGW * NB) {
        float l[NB][3]; u32x4 v[NB][3];
#pragma unroll
        for (int b = 0; b < NB; ++b) { const int tok = min(t0 + b * NGW, T - 1);
#pragma unroll
            for (int br = 0; br < 3; ++br) { l[b][br] = lse[((size_t)br * T + tok) * 4 + h]; v[b][br] = __builtin_nontemporal_load((const u32x4*)(ob + ((size_t)br * T + tok) * 512 + lane * 8)); } }
#pragma unroll
        for (int b = 0; b < NB; ++b) { const int tok = t0 + b * NGW; if (tok >= T) break;
            const float m = fmaxf(l[b][0], fmaxf(l[b][1], l[b][2]));
            float w0 = __expf(l[b][0] - m), w1 = __expf(l[b][1] - m), w2 = __expf(l[b][2] - m); const float rs = 1.0f / (w0 + w1 + w2); w0 *= rs; w1 *= rs; w2 *= rs;
            u32x4 o;
#pragma unroll
            for (int j = 0; j < 4; ++j) o[j] = cvt_pk_bf16(w0 * bflo(v[b][0][j]) + w1 * bflo(v[b][1][j]) + w2 * bflo(v[b][2][j]), w0 * bfhi(v[b][0][j]) + w1 * bfhi(v[b][1][j]) + w2 * bfhi(v[b][2][j]));
            *(u32x4*)(cat + (size_t)tok * 1024 + 512 + lane * 8) = o; }
    }
}

__device__ __forceinline__ void p6_prelude(Frame& F) {
    LAS unsigned char* misc = F.lds + MISC_OFF;
    LAS float* g2 = (LAS float*)(misc + MO_G2); LAS int* hist = (LAS int*)(misc + MO_HIST);
    __syncthreads();
    {
        const u32x4* src = (const u32x4*)(F.ws + WS_WR); u32x4 t[16];
#pragma unroll
        for (int j = 0; j < 16; ++j) t[j] = src[F.tid + NTHR * j];
#pragma unroll
        for (int j = 0; j < 16; ++j) *(LAS u32x4*)(F.lds + (size_t)(F.tid + NTHR * j) * 16) = t[j];
    }
    for (int q = F.tid; q < 1024; q += NTHR) g2[q] = F.norm_ffn_g[q];
    if (F.tid < 32) hist[F.tid] = 0;
    __syncthreads();
}
__device__ __forceinline__ void p6_router(Frame& F) {
    LAS unsigned char* Whi = F.lds; LAS unsigned char* Wlo = F.lds + 65536;
    LAS unsigned char* misc = F.lds + MISC_OFF;
    LAS float* g2 = (LAS float*)(misc + MO_G2); LAS int* hist = (LAS int*)(misc + MO_HIST); LAS int* base = (LAS int*)(misc + MO_BASE);
    const int lane = F.lane, w = F.wave, i = lane & 15, g = lane >> 4;
    const bf16_t* x1 = (const bf16_t*)(F.ws + WS_X1); unsigned char* h2u = F.ws + WS_H;
    for (int grp = F.vcu; grp * 128 < T; grp += F.G) {
        const int tok = grp * 128 + 16 * w + i;
        const bf16_t* xr = x1 + (size_t)tok * 1024 + 16 * g;
        f32x4 acc[2] = {{0.f, 0.f, 0.f, 0.f}, {0.f, 0.f, 0.f, 0.f}};
        float ss = 0.f;
#pragma unroll 1
        for (int kp = 0; kp < 8; ++kp) {
            f32x16 pa, pb;
#pragma unroll
            for (int hh = 0; hh < 2; ++hh) {
                const int kb = 2 * kp + hh;
                f32x4 y[4];
                const u32x4 xa = *(const u32x4*)(xr + 64 * kb), xb = *(const u32x4*)(xr + 64 * kb + 8);
#pragma unroll
                for (int c = 0; c < 4; ++c) {
                    const unsigned w0 = (c < 2 ? xa : xb)[2 * (c & 1)], w1 = (c < 2 ? xa : xb)[2 * (c & 1) + 1];
                    const f32x4 xv = {bflo(w0), bfhi(w0), bflo(w1), bfhi(w1)}, gv = *(const LAS f32x4*)(g2 + 64 * kb + 16 * g + 4 * c);
                    ss += (xv[0] * xv[0] + xv[1] * xv[1]) + (xv[2] * xv[2] + xv[3] * xv[3]);
                    y[c] = xv * gv;
#pragma unroll
                    for (int j = 0; j < 4; ++j) { const float q = __builtin_amdgcn_fmed3f(y[c][j] * H6_SCALE, -7.5f, 7.5f); if (hh) pb[4 * c + j] = q; else pa[4 * c + j] = q; }
                }
#pragma unroll
                for (int st = 0; st < 2; ++st) {
                    const f32x4 ya = y[2 * st], yb = y[2 * st + 1];
                    u32x4 hw = {cvt_pk_bf16(ya[0], ya[1]), cvt_pk_bf16(ya[2], ya[3]), cvt_pk_bf16(yb[0], yb[1]), cvt_pk_bf16(yb[2], yb[3])};
                    const f32x4 ra = {ya[0] - bflo(hw[0]), ya[1] - bfhi(hw[0]), ya[2] - bflo(hw[1]), ya[3] - bfhi(hw[1])};
                    const f32x4 rb = {yb[0] - bflo(hw[2]), yb[1] - bfhi(hw[2]), yb[2] - bflo(hw[3]), yb[3] - bfhi(hw[3])};
                    const bf16x8 yh = as_bf16x8(hw), yl = pack_f8(ra, rb);
#pragma unroll
                    for (int eb = 0; eb < 2; ++eb) {
                        const int off = (16 * eb + i) * 2048 + (((8 * kb + 2 * g + st) ^ i) << 4);
                        const bf16x8 wh = *(const LAS bf16x8*)(Whi + off), wl = *(const LAS bf16x8*)(Wlo + off);
                        acc[eb] = MFMA16(wh, yh, acc[eb]); acc[eb] = MFMA16(wh, yl, acc[eb]); acc[eb] = MFMA16(wl, yh, acc[eb]);
                    }
                }
            }
            const u32x6 q6 = __builtin_amdgcn_cvt_scalef32_2xpk16_fp6_f32(pa, pb, 1.0f);
            unsigned char* hp = h2u + (size_t)tok * 1024 + 128 * kp + 16 * g;
            *(u32x4*)hp = (u32x4){q6[0], q6[1], q6[2], q6[3]};
            *(u32x4*)(hp + 64) = (u32x4){q6[4], q6[5], 0u, 0u};
        }
        ss += __shfl_xor(ss, 16); ss += __shfl_xor(ss, 32);
        const float rstd = 1.0f / sqrtf(ss * (1.0f / 1024.0f) + NORM_EPS);
        float lg[32];
#pragma unroll
        for (int eb = 0; eb < 2; ++eb)
#pragma unroll
            for (int rg = 0; rg < 4; ++rg) {
                const float v = acc[eb][rg] * rstd;
#pragma unroll
                for (int gg = 0; gg < 4; ++gg) lg[16 * eb + 4 * gg + rg] = __shfl(v, 16 * gg + i);
            }
#pragma unroll
        for (int e = 0; e < 32; ++e) lg[e] += F.b_router[e];
        float tv[4]; int ti[4];
#pragma unroll
        for (int k = 0; k < 4; ++k) {
            float bv = -__builtin_inff(); int bi = 0;
#pragma unroll
            for (int e = 0; e < 32; ++e) { const bool gt = lg[e] > bv; bv = gt ? lg[e] : bv; bi = gt ? e : bi; }
            tv[k] = bv; ti[k] = bi;
#pragma unroll
            for (int e = 0; e < 32; ++e) lg[e] = (e == bi) ? -__builtin_inff() : lg[e];
        }
        float gsum = 0.f, gt4[4];
#pragma unroll
        for (int k = 0; k < 4; ++k) { gt4[k] = __expf(tv[k] - tv[0]); gsum += gt4[k]; }
        int my_e = ti[0]; float my_g = gt4[0];
#pragma unroll
        for (int k = 1; k < 4; ++k) { my_e = (g == k) ? ti[k] : my_e; my_g = (g == k) ? gt4[k] : my_g; }
        my_g /= gsum;
        const int lrank = atomicAdd((int*)(hist + my_e), 1);
        __syncthreads();
        if (F.tid < 32) { base[F.tid] = (int)atomicAdd(F.ctl + CW_CNT + 64 * F.tid, (unsigned)hist[F.tid]); }
        __syncthreads();
        const int rank = base[my_e] + lrank;
        ((int*)(F.ws + WS_RTOK))[(size_t)my_e * T + rank] = tok;
        ((float*)(F.ws + WS_RGATE))[(size_t)my_e * T + rank] = my_g;
        ((float*)(F.ws + WS_RRSTD))[(size_t)my_e * T + rank] = rstd;
        ((int*)(F.ws + WS_SLOT))[tok * 4 + g] = my_e * T + rank;
        __syncthreads();
        if (F.tid < 32) hist[F.tid] = 0;
        __syncthreads();
    }
}

struct P9Pre { f32x4 gv[4]; int sl[4][4]; };
__device__ __forceinline__ void p9_slots(Frame& F, int t0, int (&sl)[4][4]) {
    const int NGW = F.G * NWAVES; const int* slot = (const int*)(F.ws + WS_SLOT);
#pragma unroll
    for (int b = 0; b < 4; ++b) { const int tok = min(t0 + b * NGW, T - 1);
#pragma unroll
        for (int k = 0; k < 4; ++k) sl[b][k] = slot[tok * 4 + k]; }
}
__device__ __forceinline__ void p9_prelude(Frame& F, P9Pre& pre) {
#pragma unroll
    for (int j = 0; j < 4; ++j) pre.gv[j] = *((const f32x4*)F.norm_final_g + F.lane + 64 * j);
    p9_slots(F, F.vcu * NWAVES + F.wave, pre.sl);
}
__device__ __forceinline__ void p9_final(Frame& F, P9Pre& pre) {
    LAS unsigned char* misc = F.lds + MISC_OFF; const LAS int* tp = (const LAS int*)(misc + MO_TP);
    const int gw = F.vcu * NWAVES + F.wave, NGW = F.G * NWAVES, lane = F.lane;
    const bf16_t* x1 = (const bf16_t*)(F.ws + WS_X1); const unsigned char* yb = F.ws + WS_D;
    f32x4 gv[4];
#pragma unroll
    for (int j = 0; j < 4; ++j) gv[j] = pre.gv[j];
    constexpr int NB = 4;
    for (int t0 = gw; t0 < T; t0 += NGW * NB) {
        int sl[NB][4];
#pragma unroll
        for (int b = 0; b < NB; ++b)
#pragma unroll
            for (int k = 0; k < 4; ++k) { sl[b][k] = pre.sl[b][k]; asm volatile("" : "+v"(sl[b][k])); }
        if (t0 + NGW * NB < T) p9_slots(F, t0 + NGW * NB, pre.sl);
        f32x4 v[NB][4]; unsigned y[NB][4][4];
#pragma unroll
        for (int b = 0; b < NB; ++b) { const int tok = min(t0 + b * NGW, T - 1);
#pragma unroll
            for (int j = 0; j < 4; ++j) { const u32x2 xw = __builtin_nontemporal_load((const u32x2*)(x1 + (size_t)tok * 1024) + lane + 64 * j); v[b][j] = (f32x4){bflo(xw[0]), bfhi(xw[0]), bflo(xw[1]), bfhi(xw[1])}; }
#pragma unroll
            for (int k = 0; k < 4; ++k) { const int e = sl[b][k] >> 15, rank = sl[b][k] & 32767; const size_t row = (size_t)tp[e] * 256 + rank;
                const unsigned* yr = (const unsigned*)(yb + row * 1024) + lane;
#pragma unroll
                for (int j = 0; j < 4; ++j) y[b][k][j] = __builtin_nontemporal_load(yr + 64 * j); } }
#pragma unroll
        for (int b = 0; b < NB; ++b) { const int tok = t0 + b * NGW; if (tok >= T) break;
#pragma unroll
            for (int k = 0; k < 4; ++k)
#pragma unroll
                for (int j = 0; j < 4; ++j) { const f32x2 lo = __builtin_amdgcn_cvt_pk_f32_fp8((int)y[b][k][j], false), hi = __builtin_amdgcn_cvt_pk_f32_fp8((int)y[b][k][j], true);
                    v[b][j][0] += lo[0] * (1.0f / YB8_SCALE); v[b][j][1] += lo[1] * (1.0f / YB8_SCALE); v[b][j][2] += hi[0] * (1.0f / YB8_SCALE); v[b][j][3] += hi[1] * (1.0f / YB8_SCALE); }
            float ssum = 0.f;
#pragma unroll
            for (int j = 0; j < 4; ++j) ssum += (v[b][j][0] * v[b][j][0] + v[b][j][1] * v[b][j][1]) + (v[b][j][2] * v[b][j][2] + v[b][j][3] * v[b][j][3]);
            const float rstd = 1.0f / sqrtf(wave_sum(ssum) * (1.0f / 1024.0f) + NORM_EPS);
#pragma unroll
            for (int j = 0; j < 4; ++j) __builtin_nontemporal_store(v[b][j] * rstd * gv[j], (f32x4*)(F.out + (size_t)tok * 1024) + lane + 64 * j); }
    }
}

__global__ void __launch_bounds__(NTHR, 2) hybrid_fwd(Args args) {
    extern __shared__ __attribute__((aligned(16))) unsigned char lds_raw[];
    Frame F;
    F.lds = (LAS unsigned char*)lds_raw;
    F.tid = threadIdx.x; F.lane = F.tid & 63; F.wave = __builtin_amdgcn_readfirstlane(F.tid >> 6);
    F.G = gridDim.x; { const int bx = blockIdx.x; F.vcu = (F.G % 8 == 0) ? (bx % 8) * (F.G / 8) + bx / 8 : bx; }
    F.x = args.in[0]; F.norm_mix_g = args.in[1]; F.w_in = args.in[2]; F.w_out = args.in[3]; F.norm_ffn_g = args.in[4]; F.w_router = args.in[5]; F.b_router = args.in[6];
    F.w_gu = args.in[7]; F.b_gu = args.in[8]; F.w_dn = args.in[9]; F.b_dn = args.in[10]; F.norm_final_g = args.in[11];
    F.out = args.out; F.ws = args.ws; F.ctl = (unsigned*)(args.ws + WS_CTL);
    const int lo = args.ph_lo, hi = args.ph_hi;
    if (F.tid < 4) ((LAS unsigned*)(F.lds + MISC_OFF + MO_BAR))[F.tid] = 0u;
    __syncthreads();
    XcdBarrier bar; bar.bar = F.ctl + CW_BAR; bar.x = 0; bar.st = (volatile LAS unsigned*)(F.lds + MISC_OFF + MO_BAR);
    if (hi - lo > 1) bar = xcd_barrier_post(F.ctl + CW_BAR, (volatile LAS unsigned*)(F.lds + MISC_OFF + MO_BAR));
#define IN(k) (lo <= (k) && (k) < hi)
#define SEAM(k) do { if (IN(k) && IN((k) + 1)) xcd_barrier(bar); } while (0)

#define PHASE(k, ...) if (IN(k)) { { constexpr bool kRep = false; constexpr int kMode = 0; (void)kRep; (void)kMode; __VA_ARGS__ } if (REP_PH == (k)) { constexpr bool kRep = (REP_NOEPI != 0); constexpr int kMode = REP_NOEPI; (void)kRep; (void)kMode; __VA_ARGS__ } }
    P9Pre p9pre;
    PHASE(0, p0_prologue(F); )
    SEAM(0);
    PHASE(1, {
        const int bx = (int)blockIdx.x, qg = bx >> 3; const bool conv_only = (F.G == 256) && ((qg & 7) == 0);
        if (!conv_only) {
            const int Gg = (F.G == 256) ? 224 : F.G, cg = (F.G == 256) ? ((qg - (qg >> 3) - 1) * 8 + (bx & 7)) : bx;
            ProjProb S; S.so.init(T, DIN, Gg, cg); S.A = (const char*)(F.ws + WS_H); S.Bt = (const char*)(F.ws + WS_WIN); S.dst = (bf16_t*)(F.ws + WS_C);
            S.rt = (const unsigned*)(F.ws + WS_ROPE); S.misc = F.lds + MISC_OFF;
            {
                LAS unsigned* ta = (LAS unsigned*)(F.lds + MISC_OFF + MO_G2); LAS unsigned* tbb = (LAS unsigned*)(F.lds + MISC_OFF + MO_ROPEB);
                for (int r = 0; r < 2; ++r) {
                    const int q0 = r * 512 + F.wave * 64;
                    __builtin_amdgcn_global_load_lds(S.rt + q0 + F.lane, ta + q0, 4, 0, 0);
                    __builtin_amdgcn_global_load_lds(S.rt + (q0 >> 6) * 1024 + F.lane, tbb + q0, 4, 0, 0);
                }
            }
            const int kbrk = 1 + (cg & 7);
            for (int part = 0; part < 2; ++part) {
                S.i0 = part ? kbrk : 0; S.i1 = part ? (1 << 30) : kbrk;
                pg8::gemm_phase<ProjProb, kRep>(F.lds, S);
                if (part == 0 && !kRep && kMode == 0) { conv_loop<true>(F); __syncthreads(); }
            }
        }
        if (!kRep && kMode == 0) conv_loop<false>(F); })
    SEAM(1);
    PHASE(2, {
        if (kMode != 2) attn_all(F);
        if (kMode != 1) kv_units(F);
        __syncthreads(); })
    SEAM(2);
    PHASE(3, p3_scan(F); )
    SEAM(3);
    PHASE(4, {
        if (kMode != 2) retout_all(F);
        if (kMode != 1) combine_tokens(F);
        __syncthreads(); })
    SEAM(4);
    PHASE(5, {
        OutProb S; S.so.init(T, DM, F.G, (int)blockIdx.x); S.A = (const char*)(F.ws + WS_H); S.Bt = (const char*)(F.ws + WS_WOUT); S.x = F.x; S.x1 = (bf16_t*)(F.ws + WS_X1);
        pg8::gemm_phase<OutProb, kRep>(F.lds, S);
        if (!kRep && IN(6)) p6_prelude(F); })
    SEAM(5);
    if (IN(6)) { if (!IN(5)) p6_prelude(F); p6_router(F); }
    SEAM(6);
    PHASE(7, {
        moe_tables(F);
        GuProb S; S.misc = F.lds + MISC_OFF; S.G = F.G; S.vcu = F.vcu; S.A = (const char*)(F.ws + WS_H); S.Bt = (const char*)(F.ws + WS_WGU);
        S.rtok = (const int*)(F.ws + WS_RTOK); S.rrstd = (const float*)(F.ws + WS_RRSTD); S.bias = F.b_gu; S.act = F.ws + WS_C;
        pg8::gemm_phase<GuProb, kRep>(F.lds, S); })
    SEAM(7);
    PHASE(8, {
        if (lo == 8) moe_tables(F);
        DnProb S; S.misc = F.lds + MISC_OFF; S.G = F.G; S.vcu = F.vcu; S.A = (const char*)(F.ws + WS_C); S.Bt = (const char*)(F.ws + WS_WDN);
        S.rgate = (const float*)(F.ws + WS_RGATE); S.bias = F.b_dn; S.yb = F.ws + WS_D;
        pg8::gemm_phase<DnProb, kRep>(F.lds, S);
        if (!kRep && IN(9)) p9_prelude(F, p9pre); })
    SEAM(8);
    PHASE(9, { if (lo == 9) moe_tables(F); if (!IN(8)) p9_prelude(F, p9pre); p9_final(F, p9pre); })
#undef PHASE
#undef IN
#undef SEAM
}

extern "C" void kernel_launch(void* const* d_in, const int* in_sizes, int n_in, void* d_out, int out_size, void* d_ws, size_t ws_size, hipStream_t stream) {
    static int grid = 0;
    if (grid == 0) {
        if (n_in != 12 || out_size != T * DM || ws_size < WS_END) { fprintf(stderr, "kernel_launch: unexpected shapes (n_in %d out %d ws %zu)\n", n_in, out_size, ws_size); grid = -1; return; }
        int dev = 0, cus = 0, per_cu = 0;
        if (hipGetDevice(&dev) != hipSuccess || hipDeviceGetAttribute(&cus, hipDeviceAttributeMultiprocessorCount, dev) != hipSuccess) { grid = -1; return; }
        if (hipFuncSetAttribute((const void*)hybrid_fwd, hipFuncAttributeMaxDynamicSharedMemorySize, LDS_BYTES) != hipSuccess) { fprintf(stderr, "kernel_launch: hipFuncSetAttribute failed\n"); grid = -1; return; }
        if (hipOccupancyMaxActiveBlocksPerMultiprocessor(&per_cu, (const void*)hybrid_fwd, NTHR, LDS_BYTES) != hipSuccess || per_cu < 1) fprintf(stderr, "kernel_launch: occupancy query says %d\n", per_cu);
        (void)hipGetLastError();
        grid = cus;
    }
    if (grid < 0) return;
    (void)hipMemsetAsync((char*)d_ws + WS_CTL, 0, CTL_BYTES, stream);
    Args a{};
    for (int i = 0; i < 12; ++i) a.in[i] = (const float*)d_in[i];
    a.out = (float*)d_out; a.ws = (unsigned char*)d_ws;
    if (MK_N_LAUNCHES == 1) {
        a.ph_lo = 0; a.ph_hi = NPH;
        hipLaunchKernelGGL(hybrid_fwd, dim3(grid), dim3(NTHR), LDS_BYTES, stream, a);
    } else {
        for (int p = 0; p < NPH; ++p) { a.ph_lo = p; a.ph_hi = p + 1; hipLaunchKernelGGL(hybrid_fwd, dim3(grid), dim3(NTHR), LDS_BYTES, stream, a); }
    }
}
```
